# Optimizing an MI355X kernel written in HIP

```python
import math
import jax, jax.numpy as jnp
from jax import lax
import numpy as np

D_MODEL = 1024
BATCH = 8
SEQ = 2048
DEPTH = 1

GRID_W = 64
NA_HEADS = 8
NA_HEAD_DIM = 64
NA_WIN_ROWS = 8
NA_WIN_COLS = 16
DIFF_HEADS = 4
DIFF_QK_DIM = 64
DIFF_V_DIM = 2 * DIFF_QK_DIM
Q_BLOCK = 128
MEM_TOKENS = 256
MEM_HEADS = 4
MEM_HEAD_DIM = 128
D_FF = 2816
N_BRANCH = 3
NORM_EPS = 1e-6

NA_WIDTH = NA_HEADS * NA_HEAD_DIM
DIFF_QK_WIDTH = DIFF_HEADS * 2 * DIFF_QK_DIM
DIFF_V_WIDTH = DIFF_HEADS * DIFF_V_DIM
MEM_WIDTH = MEM_HEADS * MEM_HEAD_DIM
IN_WIDTH = 3 * NA_WIDTH + 2 * DIFF_QK_WIDTH + DIFF_V_WIDTH + MEM_WIDTH

kernel_name = "hybrid_gated_na_diffattn_memory_macaron"


def rmsnorm(x, g):
    xf = x.astype(jnp.float32)
    y = xf * lax.rsqrt(jnp.mean(xf * xf, axis=-1, keepdims=True) + NORM_EPS)
    return (y * g.astype(jnp.float32)).astype(x.dtype)


def swiglu(x, w_gate, w_up, w_down):
    return (jax.nn.silu(x @ w_gate) * (x @ w_up)) @ w_down


def neighbourhood_attention(q, k, v, rpb):
    b, s, h, d = q.shape
    rows = s // GRID_W
    wr = min(NA_WIN_ROWS, rows)
    wc = min(NA_WIN_COLS, GRID_W)
    to_grid = lambda t: t.reshape(b, rows, GRID_W, h, d).transpose(0, 3, 1, 2, 4)
    qg, kg, vg = to_grid(q), to_grid(k), to_grid(v)
    cols = jnp.arange(GRID_W)
    col_start = jnp.clip(cols - wc // 2, 0, GRID_W - wc)
    col_idx = col_start[:, None] + jnp.arange(wc)[None, :]
    dc = col_idx - cols[:, None] + (NA_WIN_COLS - 1)
    row_ids = jnp.arange(rows)
    row_start = jnp.clip(row_ids - wr // 2, 0, rows - wr)
    scale = d ** -0.5

    def one_row(args):
        q_row, r, rs = args
        k_band = lax.dynamic_slice_in_dim(kg, rs, wr, axis=2)
        v_band = lax.dynamic_slice_in_dim(vg, rs, wr, axis=2)
        k_win = k_band[:, :, :, col_idx, :]
        v_win = v_band[:, :, :, col_idx, :]
        logits = jnp.einsum('bhqd,bhrqcd->bhqrc', q_row, k_win).astype(jnp.float32) * scale
        dr = rs + jnp.arange(wr) - r + (NA_WIN_ROWS - 1)
        bias = rpb[:, dr[None, :, None], dc[:, None, :]]
        logits = logits + bias.astype(jnp.float32)[None]
        p = jax.nn.softmax(logits.reshape(b, h, GRID_W, wr * wc), axis=-1)
        p = p.reshape(b, h, GRID_W, wr, wc).astype(v.dtype)
        return jnp.einsum('bhqrc,bhrqcd->bhqd', p, v_win)

    out = lax.map(one_row, (qg.transpose(2, 0, 1, 3, 4), row_ids, row_start))
    return out.transpose(1, 0, 3, 2, 4).reshape(b, s, h * d)


def differential_attention(q1, q2, k1, k2, v, lam, slopes):
    b, h, s, dk = q1.shape
    dv = v.shape[-1]
    nb = s // Q_BLOCK
    scale = dk ** -0.5
    kpos = jnp.arange(s).astype(jnp.float32)

    def one_block(args):
        i, q1b, q2b = args
        qpos = (i * Q_BLOCK + jnp.arange(Q_BLOCK)).astype(jnp.float32)
        alibi = -slopes[:, None, None] * jnp.abs(qpos[:, None] - kpos[None, :])[None]
        p1 = jax.nn.softmax(jnp.einsum('bhqd,bhkd->bhqk', q1b, k1).astype(jnp.float32) * scale + alibi, axis=-1)
        p2 = jax.nn.softmax(jnp.einsum('bhqd,bhkd->bhqk', q2b, k2).astype(jnp.float32) * scale + alibi, axis=-1)
        w = (p1 - lam * p2).astype(v.dtype)
        return jnp.einsum('bhqk,bhkd->bhqd', w, v)

    blk = lambda t: t.reshape(b, h, nb, Q_BLOCK, dk).transpose(2, 0, 1, 3, 4)
    out = lax.map(one_block, (jnp.arange(nb), blk(q1), blk(q2)))
    return out.transpose(1, 2, 0, 3, 4).reshape(b, h, s, dv)


def memory_attention(q, k, v):
    b, s, h, d = q.shape
    logits = jnp.einsum('bshd,bmhd->bhsm', q, k).astype(jnp.float32) * (d ** -0.5)
    p = jax.nn.softmax(logits, axis=-1).astype(v.dtype)
    return jnp.einsum('bhsm,bmhd->bshd', p, v).reshape(b, s, h * d)


def setup_inputs(seed: int = 0) -> dict:
    key = jax.random.key(seed)
    ks = jax.random.split(key, 32)
    f32 = jnp.float32
    nrm = lambda k, shape, scale: jax.random.normal(k, shape, f32) * scale
    gain = lambda k, shape: 1.0 + 0.05 * jax.random.normal(k, shape, f32)
    L, D = DEPTH, D_MODEL
    return {
        "x": jax.random.normal(ks[0], (BATCH, SEQ, D), f32),
        "mem": jax.random.normal(ks[1], (BATCH, MEM_TOKENS, D), f32),
        "ffn1_norm": gain(ks[2], (L, D)),
        "ffn1_w_gate": nrm(ks[3], (L, D, D_FF), D ** -0.5),
        "ffn1_w_up": nrm(ks[4], (L, D, D_FF), D ** -0.5),
        "ffn1_w_down": nrm(ks[5], (L, D_FF, D), D_FF ** -0.5),
        "mix_norm": gain(ks[6], (L, D)),
        "w_in": nrm(ks[7], (L, D, IN_WIDTH), D ** -0.5),
        "na_rpb": nrm(ks[8], (L, NA_HEADS, 2 * NA_WIN_ROWS - 1, 2 * NA_WIN_COLS - 1), 0.1),
        "diff_lambda_q1": nrm(ks[9], (L, DIFF_QK_DIM), 0.1),
        "diff_lambda_k1": nrm(ks[10], (L, DIFF_QK_DIM), 0.1),
        "diff_lambda_q2": nrm(ks[11], (L, DIFF_QK_DIM), 0.1),
        "diff_lambda_k2": nrm(ks[12], (L, DIFF_QK_DIM), 0.1),
        "diff_subln": gain(ks[13], (L, DIFF_V_DIM)),
        "mem_norm": gain(ks[14], (L, D)),
        "w_mem_kv": nrm(ks[15], (L, D, 2 * MEM_WIDTH), D ** -0.5),
        "w_gate": nrm(ks[16], (L, D, N_BRANCH * D), D ** -0.5),
        "b_gate": nrm(ks[17], (L, N_BRANCH * D), 0.01),
        "w_br_na": nrm(ks[18], (L, NA_WIDTH, D), NA_WIDTH ** -0.5),
        "w_br_diff": nrm(ks[19], (L, DIFF_V_WIDTH, D), DIFF_V_WIDTH ** -0.5),
        "w_br_mem": nrm(ks[20], (L, MEM_WIDTH, D), MEM_WIDTH ** -0.5),
        "w_out": nrm(ks[21], (L, D, D), D ** -0.5),
        "ffn2_norm": gain(ks[22], (L, D)),
        "ffn2_w_gate": nrm(ks[23], (L, D, D_FF), D ** -0.5),
        "ffn2_w_up": nrm(ks[24], (L, D, D_FF), D ** -0.5),
        "ffn2_w_down": nrm(ks[25], (L, D_FF, D), D_FF ** -0.5),
        "final_norm": gain(ks[26], (D,)),
    }


def reference(x, mem, ffn1_norm, ffn1_w_gate, ffn1_w_up, ffn1_w_down, mix_norm, w_in, na_rpb,
              diff_lambda_q1, diff_lambda_k1, diff_lambda_q2, diff_lambda_k2, diff_subln,
              mem_norm, w_mem_kv, w_gate, b_gate, w_br_na, w_br_diff, w_br_mem, w_out,
              ffn2_norm, ffn2_w_gate, ffn2_w_up, ffn2_w_down, final_norm):
    b, s, d_model = x.shape
    m = mem.shape[1]
    slopes = jnp.asarray([2.0 ** (-8.0 * (i + 1) / DIFF_HEADS) for i in range(DIFF_HEADS)], jnp.float32)
    o_nq = 0
    o_nk = o_nq + NA_WIDTH
    o_nv = o_nk + NA_WIDTH
    o_dq = o_nv + NA_WIDTH
    o_dk = o_dq + DIFF_QK_WIDTH
    o_dv = o_dk + DIFF_QK_WIDTH
    o_mq = o_dv + DIFF_V_WIDTH

    for l in range(DEPTH):
        x = x + 0.5 * swiglu(rmsnorm(x, ffn1_norm[l]), ffn1_w_gate[l], ffn1_w_up[l], ffn1_w_down[l])

        h = rmsnorm(x, mix_norm[l])
        proj = h @ w_in[l]

        na_shape = (b, s, NA_HEADS, NA_HEAD_DIM)
        na_q = proj[..., o_nq:o_nk].reshape(na_shape)
        na_k = proj[..., o_nk:o_nv].reshape(na_shape)
        na_v = proj[..., o_nv:o_dq].reshape(na_shape)
        y_na = neighbourhood_attention(na_q, na_k, na_v, na_rpb[l]) @ w_br_na[l]

        dq = proj[..., o_dq:o_dk].reshape(b, s, DIFF_HEADS, 2, DIFF_QK_DIM).transpose(3, 0, 2, 1, 4)
        dk = proj[..., o_dk:o_dv].reshape(b, s, DIFF_HEADS, 2, DIFF_QK_DIM).transpose(3, 0, 2, 1, 4)
        dv = proj[..., o_dv:o_mq].reshape(b, s, DIFF_HEADS, DIFF_V_DIM).transpose(0, 2, 1, 3)
        lam_init = 0.8 - 0.6 * math.exp(-0.3 * l)
        lam = (jnp.exp(jnp.sum(diff_lambda_q1[l].astype(jnp.float32) * diff_lambda_k1[l].astype(jnp.float32)))
               - jnp.exp(jnp.sum(diff_lambda_q2[l].astype(jnp.float32) * diff_lambda_k2[l].astype(jnp.float32)))
               + lam_init)
        o_diff = differential_attention(dq[0], dq[1], dk[0], dk[1], dv, lam, slopes)
        o_diff = rmsnorm(o_diff, diff_subln[l]) * (1.0 - lam_init)
        o_diff = o_diff.transpose(0, 2, 1, 3).reshape(b, s, DIFF_V_WIDTH)
        y_diff = o_diff @ w_br_diff[l]

        mq = proj[..., o_mq:].reshape(b, s, MEM_HEADS, MEM_HEAD_DIM)
        mkv = rmsnorm(mem, mem_norm[l]) @ w_mem_kv[l]
        mk = mkv[..., :MEM_WIDTH].reshape(b, m, MEM_HEADS, MEM_HEAD_DIM)
        mv = mkv[..., MEM_WIDTH:].reshape(b, m, MEM_HEADS, MEM_HEAD_DIM)
        y_mem = memory_attention(mq, mk, mv) @ w_br_mem[l]

        g = jax.nn.sigmoid((h @ w_gate[l] + b_gate[l]).astype(jnp.float32)).astype(h.dtype)
        g = g.reshape(b, s, N_BRANCH, d_model)
        merged = g[:, :, 0] * y_na + g[:, :, 1] * y_diff + g[:, :, 2] * y_mem
        x = x + merged @ w_out[l]

        x = x + 0.5 * swiglu(rmsnorm(x, ffn2_norm[l]), ffn2_w_gate[l], ffn2_w_up[l], ffn2_w_down[l])

    return rmsnorm(x, final_norm)
```

```cpp
#include <hip/hip_runtime.h>
#include <hip/hip_cooperative_groups.h>
#include <cstdio>
#include <cstdint>
namespace cg = cooperative_groups;

#ifndef MK_N_LAUNCHES
#define MK_N_LAUNCHES 1
#endif

#define LAS __attribute__((address_space(3)))
#define DEV __device__ __forceinline__
typedef unsigned short bf16_t;
typedef short bf16x8 __attribute__((ext_vector_type(8)));
typedef short s16x4 __attribute__((ext_vector_type(4)));
typedef float f32x2 __attribute__((ext_vector_type(2)));
typedef float f32x4 __attribute__((ext_vector_type(4)));
typedef float f32x16 __attribute__((ext_vector_type(16)));
typedef unsigned u32x2 __attribute__((ext_vector_type(2)));
typedef unsigned u32x4 __attribute__((ext_vector_type(4)));
typedef __bf16 bf16x2_t __attribute__((ext_vector_type(2)));

constexpr int M = 16384, D = 1024, FF = 2816, INW = 3584, GW = 3072, SEQ = 2048, NB = 8, MEMT = 256, MEMR = NB * MEMT;
constexpr int O_NQ = 0, O_NK = 512, O_NV = 1024, O_DQ = 1536, O_DK = 2048, O_DV = 2560, O_MQ = 3072;
constexpr int ATTW = 1536;
constexpr float EPS = 1e-6f, LOG2E = 1.4426950408889634f;
constexpr int NTHR = 512, NWAVES = 8;
constexpr int LDS_BYTES = 147456;

constexpr size_t MiB = 1u << 20;
constexpr size_t WS_W1T = 0, WS_WD1T = 11 * MiB, WS_WMIX = WS_WD1T + 11 * MiB / 2, WS_WBR = WS_WMIX + 15 * MiB, WS_WOUT = WS_WBR + 3 * MiB,
                 WS_W2T = WS_WOUT + 2 * MiB, WS_WD2T = WS_W2T + 11 * MiB, WS_XB = 53 * MiB, WS_SSQ = 89 * MiB, WS_MKV = 91 * MiB, WS_OV = 96 * MiB;
constexpr size_t WS_HID = WS_OV, WS_PROJ = WS_OV, WS_GATES = WS_OV, WS_ATT = 208 * MiB, WS_X2B = 208 * MiB, WS_END = 256 * MiB;
static_assert(WS_WD2T + 11 * MiB / 2 == WS_XB, "weights end at 53 MiB");
static_assert(WS_PROJ + (size_t)M * INW * 2 == WS_ATT && WS_ATT + (size_t)M * ATTW * 2 == WS_END, "overlay map");

DEV unsigned cvtpk(float lo, float hi) { f32x2 v = {lo, hi}; bf16x2_t b = __builtin_convertvector(v, bf16x2_t); return __builtin_bit_cast(unsigned, b); }
DEV float bf_lo(unsigned w) { return __uint_as_float(w << 16); }
DEV float bf_hi(unsigned w) { return __uint_as_float(w & 0xffff0000u); }
DEV float wave_sum(float v) {
#pragma unroll
    for (int o = 1; o < 64; o <<= 1) v += __shfl_xor(v, o);
    return v;
}
DEV float row_rstd(const float* ssq, int row) {
    const f32x4* p = (const f32x4*)(ssq + (size_t)row * 16);
    const f32x4 a = p[0], b = p[1], c = p[2], d = p[3];
    const float s = ((a[0] + a[1]) + (a[2] + a[3])) + ((b[0] + b[1]) + (b[2] + b[3])) + ((c[0] + c[1]) + (c[2] + c[3])) + ((d[0] + d[1]) + (d[2] + d[3]));
    return __builtin_amdgcn_rsqf(s * (1.0f / D) + EPS);
}

namespace pg8 {
constexpr int BM = 256, BK = 64, HALF = 128, HTB = HALF * BK * 2, STAGE_BYTES = 8 * HTB, NXCD = 8, WGM = 8;
__host__ __device__ __forceinline__ int lds_byte(int r, int c) { const int st = (r >> 4) * 2 + (c >> 5), rr = r & 15, cc = c & 31, ob = rr * 64 + cc * 2; return st * 1024 + (ob ^ (((ob >> 9) & 1) << 5)); }
__host__ __device__ __forceinline__ void stage_rc(int b, int& R, int& C) { const int st = b / 1024, sb = b % 1024, swz = sb ^ (((sb >> 9) & 1) << 5); R = (st >> 1) * 16 + swz / 64; C = (st & 1) * 32 + (swz % 64) / 2; }
__host__ __device__ __forceinline__ int perm32(int rho) { const int n = rho >> 4, i = rho & 15; return 8 * (i >> 2) + 4 * n + (i & 3); }

struct Unit { int pm, pn, br; };

struct StaticOrder {
    int nM, nN, nwg;
    __device__ void init(int M_, int N_) { nM = M_ / BM; nN = N_ / BM; nwg = nM * nN; }
    __device__ void map(int L, Unit& u) const {
        int wgid = L; { const int q = nwg / NXCD, r = nwg % NXCD, xcd = wgid % NXCD, off = wgid / NXCD; wgid = (xcd < r ? xcd * (q + 1) : r * (q + 1) + (xcd - r) * q) + off; }
        const int nig = WGM * nN, gid = wgid / nig, fm = gid * WGM, gsz = (nM - fm) < WGM ? (nM - fm) : WGM;
        u.pm = fm + ((wgid % nig) % gsz); u.pn = (wgid % nig) / gsz; u.br = 0;
    }
};
struct SchedRect {
    StaticOrder so; const char* A; const char* B; size_t at, bt; int G, c;
    DEV bool next(int i, Unit& u) const { const int L = i * G + c; if (L >= so.nwg) return false; so.map(L, u); return true; }
    DEV const char* aptr(const Unit& u) const { return A + (size_t)u.pm * at; }
    DEV const char* bptr(const Unit& u) const { return B + (size_t)u.pn * bt; }
};
struct SchedP3 {
    StaticOrder so; const char* A; const char* B; size_t at, bt; int G, c;
    DEV bool next(int i, Unit& u) const {
        const int L = i * G + c;
        if (L < so.nwg) { so.map(L, u); return true; }
        const int e = L - so.nwg; if (e >= 32) return false;
        u.pm = 64 + (e >> 2); u.pn = 26 + (e & 3); u.br = 0; return true;
    }
    DEV const char* aptr(const Unit& u) const { return A + (size_t)u.pm * at; }
    DEV const char* bptr(const Unit& u) const { return B + (size_t)u.pn * bt; }
};
struct SchedBr {
    StaticOrder so; const char* A; const char* B; size_t at, bt; int G, c;
    DEV bool next(int i, Unit& u) const { const int L = (i / 3) * G + c; if (L >= so.nwg) return false; so.map(L, u); u.br = i % 3; return true; }
    DEV const char* aptr(const Unit& u) const { return A + (size_t)u.pm * at + (size_t)u.br * 512 * 2; }
    DEV const char* bptr(const Unit& u) const { return B + ((size_t)u.br * 4 + u.pn) * bt; }
};

typedef f32x4 Acc[2][2][4][2];

DEV float silu_mul(float g, float u) { return g * u * __builtin_amdgcn_rcpf(1.0f + __builtin_amdgcn_exp2f(-LOG2E * g)); }
DEV float sigm(float v) { return __builtin_amdgcn_rcpf(1.0f + __builtin_amdgcn_exp2f(-LOG2E * v)); }

struct EpiSwiglu {
    static constexpr bool PERM = true;
    bf16_t* H; const float* ssq;
    DEV void operator()(const Acc& acc, const Unit& u, int wr, int wc, int fr, int fq) const {
        const int row0 = u.pm * BM + wr * 64 + fr, col0 = u.pn * 128 + wc * 32 + 8 * fq;
#pragma unroll
        for (int ai = 0; ai < 2; ++ai)
#pragma unroll
            for (int m = 0; m < 4; ++m) {
                const int row = row0 + ai * HALF + m * 16; const float rs = row_rstd(ssq, row);
                const f32x4 g0 = acc[ai][0][m][0] * rs, g1 = acc[ai][0][m][1] * rs, u0 = acc[ai][1][m][0] * rs, u1 = acc[ai][1][m][1] * rs;
                u32x4 w;
                w.x = cvtpk(silu_mul(g0[0], u0[0]), silu_mul(g0[1], u0[1])); w.y = cvtpk(silu_mul(g0[2], u0[2]), silu_mul(g0[3], u0[3]));
                w.z = cvtpk(silu_mul(g1[0], u1[0]), silu_mul(g1[1], u1[1])); w.w = cvtpk(silu_mul(g1[2], u1[2]), silu_mul(g1[3], u1[3]));
                *(u32x4*)(H + (size_t)row * FF + col0) = w;
            }
    }
};
struct EpiResid {
    static constexpr bool PERM = false;
    const float* base; float* out; bf16_t* xb; float* ssq; float s;
    DEV void operator()(const Acc& acc, const Unit& u, int wr, int wc, int fr, int fq) const {
        const int row0 = u.pm * BM + wr * 64 + fr, col0 = u.pn * BM + wc * 32 + 4 * fq;
#pragma unroll
        for (int ai = 0; ai < 2; ++ai)
#pragma unroll
            for (int m = 0; m < 4; ++m) {
                const int row = row0 + ai * HALF + m * 16; const size_t off = (size_t)row * D + col0; float q = 0.f;
#pragma unroll
                for (int bj = 0; bj < 2; ++bj)
#pragma unroll
                    for (int n = 0; n < 2; ++n) {
                        const f32x4 b = *(const f32x4*)(base + off + bj * HALF + n * 16);
                        const f32x4 v = b + acc[ai][bj][m][n] * s;
                        *(f32x4*)(out + off + bj * HALF + n * 16) = v;
                        if (xb) { u32x2 w; w.x = cvtpk(v[0], v[1]); w.y = cvtpk(v[2], v[3]); *(u32x2*)(xb + off + bj * HALF + n * 16) = w; }
                        q += (v[0] * v[0] + v[1] * v[1]) + (v[2] * v[2] + v[3] * v[3]);
                    }
                q += __shfl_xor(q, 16); q += __shfl_xor(q, 32);
                if (fq == 0) ssq[(size_t)row * 16 + u.pn * 4 + wc] = q;
                asm volatile("" ::: "memory");
            }
    }
};
struct EpiProj {
    static constexpr bool PERM = true;
    bf16_t* P; bf16_t* MKV; const float* ssq;
    DEV void operator()(const Acc& acc, const Unit& u, int wr, int wc, int fr, int fq) const {
        const int row0 = u.pm * BM + wr * 64 + fr; const bool mem = u.pm >= 64;
        bf16_t* base = mem ? MKV + (size_t)(row0 - M) * 1024 + (u.pn - 26) * BM : P + (size_t)row0 * INW + u.pn * BM;
        const size_t ldc = mem ? 1024 : INW; base += wc * 32 + 8 * fq;
#pragma unroll
        for (int ai = 0; ai < 2; ++ai)
#pragma unroll
            for (int m = 0; m < 4; ++m) {
                const int row = row0 + ai * HALF + m * 16; const float rs = row_rstd(ssq, row);
                bf16_t* rp = base + (size_t)(ai * HALF + m * 16) * ldc;
#pragma unroll
                for (int bj = 0; bj < 2; ++bj) {
                    const f32x4 v0 = acc[ai][bj][m][0] * rs, v1 = acc[ai][bj][m][1] * rs; u32x4 w;
                    w.x = cvtpk(v0[0], v0[1]); w.y = cvtpk(v0[2], v0[3]); w.z = cvtpk(v1[0], v1[1]); w.w = cvtpk(v1[2], v1[3]);
                    *(u32x4*)(rp + bj * HALF) = w;
                }
            }
    }
};
struct EpiGate {
    static constexpr bool PERM = true;
    bf16_t* Gt; const float* ssq; const float* bias;
    DEV void operator()(const Acc& acc, const Unit& u, int wr, int wc, int fr, int fq) const {
        const int row0 = u.pm * BM + wr * 64 + fr, col0 = u.pn * BM + wc * 32 + 8 * fq;
        f32x4 bv[2][2];
#pragma unroll
        for (int bj = 0; bj < 2; ++bj)
#pragma unroll
            for (int n = 0; n < 2; ++n) bv[bj][n] = *(const f32x4*)(bias + col0 + bj * HALF + 4 * n);
#pragma unroll
        for (int ai = 0; ai < 2; ++ai)
#pragma unroll
            for (int m = 0; m < 4; ++m) {
                const int row = row0 + ai * HALF + m * 16; const float rs = row_rstd(ssq, row);
#pragma unroll
                for (int bj = 0; bj < 2; ++bj) {
                    const f32x4 v0 = acc[ai][bj][m][0] * rs + bv[bj][0], v1 = acc[ai][bj][m][1] * rs + bv[bj][1]; u32x4 w;
                    w.x = cvtpk(sigm(v0[0]), sigm(v0[1])); w.y = cvtpk(sigm(v0[2]), sigm(v0[3])); w.z = cvtpk(sigm(v1[0]), sigm(v1[1])); w.w = cvtpk(sigm(v1[2]), sigm(v1[3]));
                    *(u32x4*)(Gt + (size_t)row * GW + col0 + bj * HALF) = w;
                }
            }
    }
};
struct EpiMerge {
    static constexpr bool PERM = true;
    bf16_t* Mg; const bf16_t* Gt;
    DEV void operator()(const Acc& acc, const Unit& u, int wr, int wc, int fr, int fq) const {
        const int row0 = u.pm * BM + wr * 64 + fr, col0 = u.pn * BM + wc * 32 + 8 * fq;
#pragma unroll
        for (int ai = 0; ai < 2; ++ai)
#pragma unroll
            for (int m = 0; m < 4; ++m) {
                const int row = row0 + ai * HALF + m * 16;
#pragma unroll
                for (int bj = 0; bj < 2; ++bj) {
                    const u32x4 g = *(const u32x4*)(Gt + (size_t)row * GW + u.br * D + col0 + bj * HALF);
                    bf16_t* mp = Mg + (size_t)row * D + col0 + bj * HALF;
                    const f32x4 a0 = acc[ai][bj][m][0], a1 = acc[ai][bj][m][1];
                    float v[8] = {bf_lo(g.x) * a0[0], bf_hi(g.x) * a0[1], bf_lo(g.y) * a0[2], bf_hi(g.y) * a0[3], bf_lo(g.z) * a1[0], bf_hi(g.z) * a1[1], bf_lo(g.w) * a1[2], bf_hi(g.w) * a1[3]};
                    if (u.br != 0) { const u32x4 o = *(const u32x4*)mp;
                        v[0] += bf_lo(o.x); v[1] += bf_hi(o.x); v[2] += bf_lo(o.y); v[3] += bf_hi(o.y); v[4] += bf_lo(o.z); v[5] += bf_hi(o.z); v[6] += bf_lo(o.w); v[7] += bf_hi(o.w); }
                    u32x4 w; w.x = cvtpk(v[0], v[1]); w.y = cvtpk(v[2], v[3]); w.z = cvtpk(v[4], v[5]); w.w = cvtpk(v[6], v[7]);
                    *(u32x4*)mp = w;
                }
            }
        asm volatile("s_waitcnt vmcnt(0)" ::: "memory");
    }
};

template <class Epi, class Sched>
DEV void gemm_phase(LAS unsigned char* lds, const int K, const int lda, const int ldb, const Sched& S, const Epi& E) {
    const int tid = threadIdx.x, wid = __builtin_amdgcn_readfirstlane(tid >> 6), lane = tid & 63, wr = wid >> 2, wc = wid & 3, fr = lane & 15, fq = lane >> 4;
    const int nt = K / BK;
    unsigned voffA[2], voffB[2];
#pragma unroll
    for (int i = 0; i < 2; ++i) { int R, C; stage_rc(tid * 16 + i * 8192, R, C); const int Rb = Epi::PERM ? ((R & ~31) + perm32(R & 31)) : R;
        voffA[i] = (unsigned)(R * lda + C) * 2u; voffB[i] = (unsigned)(Rb * ldb + C) * 2u; }
    const size_t kstep = (size_t)(BK * 2);
    const size_t hstepA = (size_t)HALF * lda * 2, hstepB = (size_t)HALF * ldb * 2;
    const unsigned ldsw = (unsigned)wid * 1024u;
    const int aoff = lds_byte(wr * 64 + fr, fq * 8), boff = lds_byte(wc * 32 + fr, fq * 8);
#define PG8_SA(b, h) (((b) * 2 + (h)) * HTB)
#define PG8_SB(b, h) ((4 + (b) * 2 + (h)) * HTB)
#define PG8_STAGE(bufoff, gbase, voff) do { _Pragma("unroll") for (int _i = 0; _i < 2; ++_i) \
        __builtin_amdgcn_global_load_lds((const unsigned*)((const char*)(gbase) + (voff)[_i]), (LAS unsigned*)(lds + (bufoff) + ldsw + _i * 8192), 16, 0, 0); } while (0)
#define PG8_LDA(dst, b, h) do { _Pragma("unroll") for (int m = 0; m < 4; ++m) _Pragma("unroll") for (int k = 0; k < 2; ++k) dst[m][k] = *(const LAS bf16x8*)(lds + PG8_SA(b, h) + aoff + m * 2048 + k * 1024); } while (0)
#define PG8_LDB(dst, b, h) do { _Pragma("unroll") for (int n = 0; n < 2; ++n) _Pragma("unroll") for (int k = 0; k < 2; ++k) dst[n][k] = *(const LAS bf16x8*)(lds + PG8_SB(b, h) + boff + n * 2048 + k * 1024); } while (0)
#define PG8_MMA(ai, bj, At, Bt) do { __builtin_amdgcn_s_setprio(1); _Pragma("unroll") for (int m = 0; m < 4; ++m) _Pragma("unroll") for (int n = 0; n < 2; ++n) _Pragma("unroll") for (int k = 0; k < 2; ++k) \
        acc[ai][bj][m][n] = __builtin_amdgcn_mfma_f32_16x16x32_bf16(Bt[n][k], At[m][k], acc[ai][bj][m][n], 0, 0, 0); __builtin_amdgcn_s_setprio(0); } while (0)
#define PG8_WAIT_V(n) asm volatile("s_waitcnt vmcnt(" #n ")" ::: "memory")
#define PG8_WAIT_L(n) asm volatile("s_waitcnt lgkmcnt(" #n ")" ::: "memory")
#define PG8_BAR __builtin_amdgcn_s_barrier()
#define PG8_SCHED __builtin_amdgcn_sched_barrier(0)
    Unit cur, nxt; int ui = 0;
    if (!S.next(0, cur)) return;
    Acc acc;
#pragma unroll
    for (int a = 0; a < 2; ++a)
#pragma unroll
        for (int b = 0; b < 2; ++b)
#pragma unroll
            for (int m = 0; m < 4; ++m)
#pragma unroll
                for (int n = 0; n < 2; ++n) acc[a][b][m][n] = (f32x4){0.f, 0.f, 0.f, 0.f};
    bf16x8 At[4][2], B0[2][2], B1[2][2];
    const char* cA = S.aptr(cur); const char* cB = S.bptr(cur);
    PG8_STAGE(PG8_SB(0, 0), cB, voffB); PG8_STAGE(PG8_SB(0, 1), cB + hstepB, voffB); PG8_STAGE(PG8_SA(0, 0), cA, voffA); PG8_STAGE(PG8_SA(0, 1), cA + hstepA, voffA);
    if (wr == 1) PG8_BAR;
    PG8_WAIT_V(2); PG8_BAR;
    PG8_STAGE(PG8_SB(1, 0), cB + kstep, voffB); PG8_STAGE(PG8_SA(1, 0), cA + kstep, voffA); PG8_STAGE(PG8_SB(1, 1), cB + hstepB + kstep, voffB);
    PG8_WAIT_V(6); PG8_BAR;
    for (;;) {
        const bool has_next = S.next(ui + 1, nxt);
        const char* nA = has_next ? S.aptr(nxt) : cA; const char* nB = has_next ? S.bptr(nxt) : cB;
        for (int t = 0; t < nt; t += 2) {
            const bool last = (t == nt - 2);
            const char* a1 = cA + (size_t)(t + 1) * kstep;
            const char* a2 = last ? nA : cA + (size_t)(t + 2) * kstep; const char* b2 = last ? nB : cB + (size_t)(t + 2) * kstep;
            const char* a3 = a2 + kstep; const char* b3 = b2 + kstep;
            PG8_LDB(B0, 0, 0); PG8_LDB(B1, 0, 1); PG8_SCHED; PG8_LDA(At, 0, 0); PG8_STAGE(PG8_SA(1, 1), a1 + hstepA, voffA);
            PG8_WAIT_V(8); PG8_WAIT_L(0); PG8_BAR; PG8_MMA(0, 0, At, B0); PG8_MMA(0, 1, At, B1); PG8_BAR; PG8_SCHED;
            PG8_LDA(At, 0, 1); PG8_STAGE(PG8_SB(0, 0), b2, voffB); PG8_STAGE(PG8_SB(0, 1), b2 + hstepB, voffB); PG8_STAGE(PG8_SA(0, 0), a2, voffA);
            PG8_WAIT_V(8); PG8_WAIT_L(0); PG8_BAR; PG8_MMA(1, 0, At, B0); PG8_MMA(1, 1, At, B1); PG8_BAR; PG8_SCHED;
            PG8_LDB(B0, 1, 0); PG8_LDB(B1, 1, 1); PG8_SCHED; PG8_LDA(At, 1, 0); PG8_STAGE(PG8_SA(0, 1), a2 + hstepA, voffA);
            PG8_WAIT_V(8); PG8_WAIT_L(0); PG8_BAR; PG8_MMA(0, 0, At, B0); PG8_MMA(0, 1, At, B1); PG8_BAR; PG8_SCHED;
            PG8_LDA(At, 1, 1); PG8_STAGE(PG8_SB(1, 0), b3, voffB); PG8_STAGE(PG8_SB(1, 1), b3 + hstepB, voffB); PG8_STAGE(PG8_SA(1, 0), a3, voffA);
            PG8_WAIT_V(8); PG8_WAIT_L(0); PG8_BAR; PG8_MMA(1, 0, At, B0); PG8_MMA(1, 1, At, B1); PG8_BAR; PG8_SCHED;
        }
        if (wr == 0) PG8_BAR;
        E(acc, cur, wr, wc, fr, fq);
        if (!has_next) break;
#pragma unroll
        for (int a = 0; a < 2; ++a)
#pragma unroll
            for (int b = 0; b < 2; ++b)
#pragma unroll
                for (int m = 0; m < 4; ++m)
#pragma unroll
                    for (int n = 0; n < 2; ++n) acc[a][b][m][n] = (f32x4){0.f, 0.f, 0.f, 0.f};
        cur = nxt; cA = nA; cB = nB; ++ui;
        if (wr == 1) PG8_BAR;
    }
    PG8_WAIT_V(0);
    PG8_BAR;
#undef PG8_SA
#undef PG8_SB
#undef PG8_STAGE
#undef PG8_LDA
#undef PG8_LDB
#undef PG8_MMA
#undef PG8_WAIT_V
#undef PG8_WAIT_L
#undef PG8_BAR
#undef PG8_SCHED
}
}

DEV void transpose_item(const float* W, int K, int N, bf16_t* WT, int k0, int n0, int dst_row0, const float* gain, LAS float* scr, int lane) {
#pragma unroll 8
    for (int i = 0; i < 32; ++i) { const int kk = 2 * i + (lane >> 5); float v = W[(size_t)(k0 + kk) * N + n0 + (lane & 31)]; if (gain) v *= gain[k0 + kk]; scr[kk * 33 + (lane & 31)] = v; }
    asm volatile("s_waitcnt lgkmcnt(0)" ::: "memory");
    const int c = lane & 7;
#pragma unroll
    for (int j = 0; j < 4; ++j) { const int n = (lane >> 3) + 8 * j; const LAS float* s = scr + (8 * c) * 33 + n;
        u32x4 o; o.x = cvtpk(s[0 * 33], s[1 * 33]); o.y = cvtpk(s[2 * 33], s[3 * 33]); o.z = cvtpk(s[4 * 33], s[5 * 33]); o.w = cvtpk(s[6 * 33], s[7 * 33]);
        *(u32x4*)(WT + (size_t)(dst_row0 + n) * K + k0 + 8 * c) = o; }
    asm volatile("s_waitcnt lgkmcnt(0)" ::: "memory");
}
template <int MODE>
DEV void transpose_matrix(const float* W, int K, int N, bf16_t* WT, int row_off, const float* gain, LAS float* scr, int gw, int ngw, int lane) {
    const int nblk = N / 32, nitems = (K / 64) * nblk;
    for (int it = gw; it < nitems; it += ngw) {
        const int kb = it / nblk, nb = it % nblk, n0 = 32 * nb;
        const int dr = MODE == 0 ? row_off + n0 : 256 * (n0 >> 7) + 128 * (MODE - 1) + (n0 & 127);
        transpose_item(W, K, N, WT, 64 * kb, n0, dr, gain, scr, lane);
    }
}
DEV void row_to_bf16(const float* xrow, bf16_t* orow, float* ssq_row, int lane) {
    const f32x4* xr = (const f32x4*)xrow + lane; f32x4 v[4]; float s = 0.f;
#pragma unroll
    for (int j = 0; j < 4; ++j) { v[j] = xr[64 * j]; s += (v[j][0] * v[j][0] + v[j][1] * v[j][1]) + (v[j][2] * v[j][2] + v[j][3] * v[j][3]); }
    s = wave_sum(s);
    u32x2* o8 = (u32x2*)orow + lane;
#pragma unroll
    for (int j = 0; j < 4; ++j) { u32x2 w; w.x = cvtpk(v[j][0], v[j][1]); w.y = cvtpk(v[j][2], v[j][3]); o8[64 * j] = w; }
    if (lane < 16) ssq_row[lane] = lane == 0 ? s : 0.f;
}

#define MFMA32(a, b, c) __builtin_amdgcn_mfma_f32_32x32x16_bf16((a), (b), (c), 0, 0, 0)
typedef short v4i16_t __attribute__((ext_vector_type(4)));
DEV s16x4 vtr(const LAS char* p) { return __builtin_bit_cast(s16x4, __builtin_amdgcn_ds_read_tr16_b64_v4i16((LAS v4i16_t*)p)); }
DEV int crow(int r, int hi) { return (r & 3) + 8 * (r >> 2) + 4 * hi; }
constexpr float NEG_BIG = -3.0e38f;

constexpr int ALDS_V = 0, ALDS_K = 36864, ALDS_X = 70656;
static_assert(ALDS_X + 65536 <= 131072 + 8192, "attention LDS");

template <int NCH> DEV void tile_gload(u32x4 (&st)[NCH / 8], const char* g, size_t gp, int tid) {
#pragma unroll
    for (int i = 0; i < NCH / 8; ++i) { const int c = tid + NTHR * i, row = c / NCH, ch = c % NCH; st[i] = *(const u32x4*)(g + (size_t)row * gp + ch * 16); }
}
template <int NCH, int PITCH> DEV void tile_swrite(const u32x4 (&st)[NCH / 8], LAS char* l, int tid) {
#pragma unroll
    for (int i = 0; i < NCH / 8; ++i) { const int c = tid + NTHR * i, row = c / NCH, ch = c % NCH; *(LAS u32x4*)(l + row * PITCH + ch * 16) = st[i]; }
}
template <int DK, int KP> DEV void qk_tile(f32x16& p0, f32x16& p1, const LAS char* Kt, const bf16x8 (&qf)[DK / 16], int r32, int hi) {
    const LAS char* ka = Kt + r32 * KP + hi * 16;
#pragma unroll
    for (int r = 0; r < 16; ++r) { p0[r] = 0.f; p1[r] = 0.f; }
#pragma unroll
    for (int ks = 0; ks < DK / 16; ++ks) {
        const bf16x8 a0 = *(const LAS bf16x8*)(ka + ks * 32), a1 = *(const LAS bf16x8*)(ka + 32 * KP + ks * 32);
        p0 = MFMA32(a0, qf[ks], p0); p1 = MFMA32(a1, qf[ks], p1);
    }
}
template <int DV, int VP> DEV void softmax_pv(f32x16& p0, f32x16& p1, f32x16 (&o)[DV / 32], float& m, float& l, const LAS char* Vt, int lane) {
    float mx = fmaxf(p0[0], p1[0]);
#pragma unroll
    for (int r = 1; r < 16; ++r) mx = fmaxf(mx, fmaxf(p0[r], p1[r]));
    mx = fmaxf(mx, __shfl_xor(mx, 32));
    const float mnew = fmaxf(m, mx), alpha = __builtin_amdgcn_exp2f(m - mnew);
    m = mnew; float s = 0.f;
#pragma unroll
    for (int r = 0; r < 16; ++r) { p0[r] = __builtin_amdgcn_exp2f(p0[r] - mnew); p1[r] = __builtin_amdgcn_exp2f(p1[r] - mnew); s += p0[r] + p1[r]; }
    l = l * alpha + s;
    if (__any(alpha != 1.0f)) {
#pragma unroll
        for (int d = 0; d < DV / 32; ++d)
#pragma unroll
            for (int r = 0; r < 16; ++r) o[d][r] *= alpha;
    }
    const int hi = lane >> 5;
    const LAS char* va = Vt + (4 * hi + ((lane & 15) >> 2)) * VP + (16 * ((lane >> 4) & 1) + 4 * (lane & 3)) * 2;
#pragma unroll
    for (int s4 = 0; s4 < 4; ++s4) {
        u32x4 pw;
        if (s4 == 0) { pw.x = cvtpk(p0[0], p0[1]); pw.y = cvtpk(p0[2], p0[3]); pw.z = cvtpk(p0[4], p0[5]); pw.w = cvtpk(p0[6], p0[7]); }
        else if (s4 == 1) { pw.x = cvtpk(p0[8], p0[9]); pw.y = cvtpk(p0[10], p0[11]); pw.z = cvtpk(p0[12], p0[13]); pw.w = cvtpk(p0[14], p0[15]); }
        else if (s4 == 2) { pw.x = cvtpk(p1[0], p1[1]); pw.y = cvtpk(p1[2], p1[3]); pw.z = cvtpk(p1[4], p1[5]); pw.w = cvtpk(p1[6], p1[7]); }
        else { pw.x = cvtpk(p1[8], p1[9]); pw.y = cvtpk(p1[10], p1[11]); pw.z = cvtpk(p1[12], p1[13]); pw.w = cvtpk(p1[14], p1[15]); }
        const bf16x8 pf = __builtin_bit_cast(bf16x8, pw);
#pragma unroll
        for (int d = 0; d < DV / 32; ++d) {
            const s16x4 lo = vtr(va + (16 * s4) * VP + d * 64), hh = vtr(va + (16 * s4 + 8) * VP + d * 64);
            const bf16x8 vf = __builtin_shufflevector(lo, hh, 0, 1, 2, 3, 4, 5, 6, 7);
            o[d] = MFMA32(vf, pf, o[d]);
        }
    }
}
template <int DV> DEV void store_ot(const f32x16 (&o)[DV / 32], float inv, bf16_t* orow, int hi) {
#pragma unroll
    for (int d = 0; d < DV / 32; ++d)
#pragma unroll
        for (int g = 0; g < 4; ++g) { u32x2 w; w.x = cvtpk(o[d][4 * g] * inv, o[d][4 * g + 1] * inv); w.y = cvtpk(o[d][4 * g + 2] * inv, o[d][4 * g + 3] * inv);
            *(u32x2*)(orow + 32 * d + 8 * g + 4 * hi) = w; }
}

struct AttnArgs { const bf16_t* proj; const bf16_t* mkv; bf16_t* att; const float* rpb; const float* lq1; const float* lk1; const float* lq2; const float* lk2; const float* subln; };

DEV void diff_unit(const AttnArgs& A, LAS char* lds, int b, int h, int qb, float lam) {
    constexpr int KP = 272, VP = 320, NT = SEQ / 64;
    const int tid = threadIdx.x, lane = tid & 63, r32 = lane & 31, hi = lane >> 5, wid = __builtin_amdgcn_readfirstlane(tid >> 6), map = wid >> 2;
    const size_t rowb = (size_t)b * SEQ; const int q0 = qb * 128 + (wid & 3) * 32;
    const bf16_t* qp = A.proj + (rowb + q0 + r32) * INW + O_DQ + h * 128 + map * 64 + hi * 8;
    bf16x8 qf[4];
#pragma unroll
    for (int ks = 0; ks < 4; ++ks) qf[ks] = *(const bf16x8*)(qp + ks * 16);
    const char* kg = (const char*)(A.proj + rowb * INW + O_DK + h * 128); const char* vg = (const char*)(A.proj + rowb * INW + O_DV + h * 128);
    const size_t gp = (size_t)INW * 2;
    f32x16 o[4];
#pragma unroll
    for (int d = 0; d < 4; ++d)
#pragma unroll
        for (int r = 0; r < 16; ++r) o[d][r] = 0.f;
    float m = -1.0e30f, l = 0.f;
    const float c2 = 0.125f * LOG2E, sl2 = exp2f(-2.0f * (float)(h + 1)) * LOG2E;
    const float qpos = (float)(q0 + r32 - 4 * hi);
    u32x4 ks_[2], vs_[2];
    tile_gload<16>(ks_, kg, gp, tid); tile_gload<16>(vs_, vg, gp, tid);
    for (int t = 0; t < NT; ++t) {
        __syncthreads();
        tile_swrite<16, KP>(ks_, lds + ALDS_K, tid); tile_swrite<16, VP>(vs_, lds + ALDS_V, tid);
        __syncthreads();
        if (t + 1 < NT) { tile_gload<16>(ks_, kg + (size_t)(t + 1) * 64 * gp, gp, tid); tile_gload<16>(vs_, vg + (size_t)(t + 1) * 64 * gp, gp, tid); }
        f32x16 p0, p1;
        qk_tile<64, KP>(p0, p1, lds + ALDS_K + map * 128, qf, r32, hi);
        const float dq = qpos - (float)(t * 64);
#pragma unroll
        for (int r = 0; r < 16; ++r) { const float kr = (float)((r & 3) + 8 * (r >> 2));
            p0[r] = p0[r] * c2 - sl2 * fabsf(dq - kr); p1[r] = p1[r] * c2 - sl2 * fabsf(dq - (kr + 32.f)); }
        softmax_pv<128, VP>(p0, p1, o, m, l, lds + ALDS_V, lane);
    }
    l += __shfl_xor(l, 32);
    const float inv = (map ? lam : 1.0f) / l;
    LAS f32x4* xch = (LAS f32x4*)(lds + ALDS_X + (wid & 3) * 16384) + lane;
    if (map) {
#pragma unroll
        for (int d = 0; d < 4; ++d)
#pragma unroll
            for (int g = 0; g < 4; ++g) xch[(d * 4 + g) * 64] = (f32x4){o[d][4 * g] * inv, o[d][4 * g + 1] * inv, o[d][4 * g + 2] * inv, o[d][4 * g + 3] * inv};
    }
    __syncthreads();
    if (!map) {
        float ss = 0.f;
#pragma unroll
        for (int d = 0; d < 4; ++d)
#pragma unroll
            for (int g = 0; g < 4; ++g) { const f32x4 x2 = xch[(d * 4 + g) * 64];
#pragma unroll
                for (int i = 0; i < 4; ++i) { const float v = o[d][4 * g + i] * inv - x2[i]; o[d][4 * g + i] = v; ss += v * v; } }
        ss += __shfl_xor(ss, 32);
        const float rn = __builtin_amdgcn_rsqf(ss * (1.0f / 128.0f) + EPS) * 0.8f;
        bf16_t* orow = A.att + (rowb + q0 + r32) * ATTW + 512 + h * 128;
#pragma unroll
        for (int d = 0; d < 4; ++d)
#pragma unroll
            for (int g = 0; g < 4; ++g) { const f32x4 sg = *(const f32x4*)(A.subln + 32 * d + 8 * g + 4 * hi); u32x2 w;
                w.x = cvtpk(o[d][4 * g] * rn * sg[0], o[d][4 * g + 1] * rn * sg[1]); w.y = cvtpk(o[d][4 * g + 2] * rn * sg[2], o[d][4 * g + 3] * rn * sg[3]);
                *(u32x2*)(orow + 32 * d + 8 * g + 4 * hi) = w; }
    }
}
DEV void na_unit(const AttnArgs& A, LAS char* lds, int b, int r, int hg) {
    constexpr int KP = 528, VP = 576;
    const int tid = threadIdx.x, lane = tid & 63, r32 = lane & 31, hi = lane >> 5, wid = __builtin_amdgcn_readfirstlane(tid >> 6), hh = wid >> 1, head = hg * 4 + hh;
    const size_t rowb = (size_t)b * SEQ; const int c = (wid & 1) * 32 + r32;
    const bf16_t* qp = A.proj + (rowb + r * 64 + c) * INW + O_NQ + head * 64 + hi * 8;
    bf16x8 qf[4];
#pragma unroll
    for (int ks = 0; ks < 4; ++ks) qf[ks] = *(const bf16x8*)(qp + ks * 16);
    const int rs = min(max(r - 4, 0), 24), cs = min(max(c - 8, 0), 48);
    const char* kg = (const char*)(A.proj + (rowb + rs * 64) * INW + O_NK + hg * 256); const char* vg = (const char*)(A.proj + (rowb + rs * 64) * INW + O_NV + hg * 256);
    const size_t gp = (size_t)INW * 2;
    const LAS float* tab = (const LAS float*)(lds + ALDS_X) + head * 465;
    f32x16 o[2];
#pragma unroll
    for (int d = 0; d < 2; ++d)
#pragma unroll
        for (int rr = 0; rr < 16; ++rr) o[d][rr] = 0.f;
    float m = -1.0e30f, l = 0.f; const float c2 = 0.125f * LOG2E;
    u32x4 ks_[4], vs_[4];
    tile_gload<32>(ks_, kg, gp, tid); tile_gload<32>(vs_, vg, gp, tid);
    for (int j = 0; j < 8; ++j) {
        __syncthreads();
        tile_swrite<32, KP>(ks_, lds + ALDS_K, tid); tile_swrite<32, VP>(vs_, lds + ALDS_V, tid);
        __syncthreads();
        if (j + 1 < 8) { tile_gload<32>(ks_, kg + (size_t)(j + 1) * 64 * gp, gp, tid); tile_gload<32>(vs_, vg + (size_t)(j + 1) * 64 * gp, gp, tid); }
        f32x16 p0, p1;
        qk_tile<64, KP>(p0, p1, lds + ALDS_K + hh * 128, qf, r32, hi);
        const int dr = rs + j - r + 7; const LAS float* trow = tab + dr * 31 + 15 - c;
#pragma unroll
        for (int rr = 0; rr < 16; ++rr) {
            const int kc0 = crow(rr, hi), kc1 = kc0 + 32;
            const bool v0 = (unsigned)(kc0 - cs) < 16u, v1 = (unsigned)(kc1 - cs) < 16u;
            const float b0 = trow[v0 ? kc0 : c], b1 = trow[v1 ? kc1 : c];
            p0[rr] = v0 ? p0[rr] * c2 + b0 : NEG_BIG; p1[rr] = v1 ? p1[rr] * c2 + b1 : NEG_BIG;
        }
        softmax_pv<64, VP>(p0, p1, o, m, l, lds + ALDS_V + hh * 128, lane);
    }
    l += __shfl_xor(l, 32);
    store_ot<64>(o, 1.0f / l, A.att + (rowb + r * 64 + c) * ATTW + head * 64, hi);
}
DEV void mem_unit(const AttnArgs& A, LAS char* lds, int b, int h, int qb) {
    constexpr int KP = 272, VP = 320;
    const int tid = threadIdx.x, lane = tid & 63, r32 = lane & 31, hi = lane >> 5, wid = __builtin_amdgcn_readfirstlane(tid >> 6);
    const size_t row = (size_t)b * SEQ + qb * 256 + wid * 32 + r32;
    const bf16_t* qp = A.proj + row * INW + O_MQ + h * 128 + hi * 8;
    bf16x8 qf[8];
#pragma unroll
    for (int ks = 0; ks < 8; ++ks) qf[ks] = *(const bf16x8*)(qp + ks * 16);
    const char* kg = (const char*)(A.mkv + (size_t)b * MEMT * 1024 + h * 128); const char* vg = kg + 512 * 2;
    const size_t gp = 1024 * 2;
    f32x16 o[4];
#pragma unroll
    for (int d = 0; d < 4; ++d)
#pragma unroll
        for (int rr = 0; rr < 16; ++rr) o[d][rr] = 0.f;
    float m = -1.0e30f, l = 0.f; const float c2 = 0.08838834764831845f * LOG2E;
    u32x4 ks_[2], vs_[2];
    tile_gload<16>(ks_, kg, gp, tid); tile_gload<16>(vs_, vg, gp, tid);
    for (int t = 0; t < 4; ++t) {
        __syncthreads();
        tile_swrite<16, KP>(ks_, lds + ALDS_K, tid); tile_swrite<16, VP>(vs_, lds + ALDS_V, tid);
        __syncthreads();
        if (t + 1 < 4) { tile_gload<16>(ks_, kg + (size_t)(t + 1) * 64 * gp, gp, tid); tile_gload<16>(vs_, vg + (size_t)(t + 1) * 64 * gp, gp, tid); }
        f32x16 p0, p1;
        qk_tile<128, KP>(p0, p1, lds + ALDS_K, qf, r32, hi);
#pragma unroll
        for (int rr = 0; rr < 16; ++rr) { p0[rr] *= c2; p1[rr] *= c2; }
        softmax_pv<128, VP>(p0, p1, o, m, l, lds + ALDS_V, lane);
    }
    l += __shfl_xor(l, 32);
    store_ot<128>(o, 1.0f / l, A.att + row * ATTW + 1024 + h * 128, hi);
}
DEV void attention_phase(const AttnArgs& A, LAS char* lds, int c, int G) {
    const int lane = threadIdx.x & 63;
    const float lam = __expf(wave_sum(A.lq1[lane] * A.lk1[lane])) - __expf(wave_sum(A.lq2[lane] * A.lk2[lane])) + 0.2f;
    for (int u = c; u < NB * 4 * 16; u += G) diff_unit(A, lds, u >> 6, (u >> 4) & 3, u & 15, lam);
    __syncthreads();
    for (int i = threadIdx.x; i < 8 * 15 * 31; i += NTHR) ((LAS float*)(lds + ALDS_X))[i] = A.rpb[i] * LOG2E;
    for (int u = c; u < NB * 32 * 2; u += G) na_unit(A, lds, u >> 6, (u >> 1) & 31, u & 1);
    for (int u = c; u < NB * 4 * 8; u += G) mem_unit(A, lds, u >> 5, (u >> 3) & 3, u & 7);
}

struct Args { const float* in[27]; float* out; unsigned char* ws; int ph_lo, ph_hi, coop, pad; };

__global__ void __launch_bounds__(NTHR, 2) fwd_megakernel(Args a) {
    extern __shared__ __attribute__((aligned(16))) unsigned char lds_raw[];
    LAS unsigned char* lds = (LAS unsigned char*)lds_raw;
    cg::grid_group grid = cg::this_grid();
    const int tid = threadIdx.x, lane = tid & 63, wave = __builtin_amdgcn_readfirstlane(tid >> 6);
    const int G = gridDim.x, c = blockIdx.x;
    unsigned char* ws = a.ws;
    const float *x = a.in[0], *mem = a.in[1], *ffn1_norm = a.in[2], *ffn1_wg = a.in[3], *ffn1_wu = a.in[4], *ffn1_wd = a.in[5], *mix_norm = a.in[6], *w_in = a.in[7], *na_rpb = a.in[8],
                *lq1 = a.in[9], *lk1 = a.in[10], *lq2 = a.in[11], *lk2 = a.in[12], *subln = a.in[13], *mem_norm = a.in[14], *w_mem_kv = a.in[15], *w_gate = a.in[16], *b_gate = a.in[17],
                *w_br_na = a.in[18], *w_br_diff = a.in[19], *w_br_mem = a.in[20], *w_out = a.in[21], *ffn2_norm = a.in[22], *ffn2_wg = a.in[23], *ffn2_wu = a.in[24], *ffn2_wd = a.in[25], *final_norm = a.in[26];
    bf16_t *W1T = (bf16_t*)(ws + WS_W1T), *WD1T = (bf16_t*)(ws + WS_WD1T), *WMIX = (bf16_t*)(ws + WS_WMIX), *WBR = (bf16_t*)(ws + WS_WBR), *WOUT = (bf16_t*)(ws + WS_WOUT),
           *W2T = (bf16_t*)(ws + WS_W2T), *WD2T = (bf16_t*)(ws + WS_WD2T), *XB = (bf16_t*)(ws + WS_XB), *MKV = (bf16_t*)(ws + WS_MKV), *HID = (bf16_t*)(ws + WS_HID),
           *PROJ = (bf16_t*)(ws + WS_PROJ), *GATES = (bf16_t*)(ws + WS_GATES), *ATT = (bf16_t*)(ws + WS_ATT), *X2B = (bf16_t*)(ws + WS_X2B);
    float* SSQ = (float*)(ws + WS_SSQ); float* out = a.out;
    const int lo = a.ph_lo, hi = a.ph_hi;
#define IN(k) (lo <= (k) && (k) < hi)
#define SEAM(k) do { if (IN(k) && IN((k) + 1)) { if (a.coop) grid.sync(); } } while (0)

    if (IN(0)) {
        LAS float* scr = (LAS float*)(lds + wave * 16384);
        const int gw = c * NWAVES + wave, ngw = G * NWAVES;
        transpose_matrix<1>(ffn1_wg, D, FF, W1T, 0, ffn1_norm, scr, gw, ngw, lane);
        transpose_matrix<2>(ffn1_wu, D, FF, W1T, 0, ffn1_norm, scr, gw, ngw, lane);
        transpose_matrix<0>(ffn1_wd, FF, D, WD1T, 0, nullptr, scr, gw, ngw, lane);
        transpose_matrix<0>(w_in, D, INW, WMIX, 0, mix_norm, scr, gw, ngw, lane);
        transpose_matrix<0>(w_gate, D, GW, WMIX, INW, mix_norm, scr, gw, ngw, lane);
        transpose_matrix<0>(w_mem_kv, D, 1024, WMIX, INW + GW, mem_norm, scr, gw, ngw, lane);
        transpose_matrix<0>(w_br_na, 512, D, WBR, 0, nullptr, scr, gw, ngw, lane);
        transpose_matrix<0>(w_br_diff, 512, D, WBR, D, nullptr, scr, gw, ngw, lane);
        transpose_matrix<0>(w_br_mem, 512, D, WBR, 2 * D, nullptr, scr, gw, ngw, lane);
        transpose_matrix<0>(w_out, D, D, WOUT, 0, nullptr, scr, gw, ngw, lane);
        transpose_matrix<1>(ffn2_wg, D, FF, W2T, 0, ffn2_norm, scr, gw, ngw, lane);
        transpose_matrix<2>(ffn2_wu, D, FF, W2T, 0, ffn2_norm, scr, gw, ngw, lane);
        transpose_matrix<0>(ffn2_wd, FF, D, WD2T, 0, nullptr, scr, gw, ngw, lane);
        for (int r = gw; r < M + MEMR; r += ngw) row_to_bf16(r < M ? x + (size_t)r * D : mem + (size_t)(r - M) * D, XB + (size_t)r * D, SSQ + (size_t)r * 16, lane);
    }
    SEAM(0);
    if (IN(1)) {
        pg8::SchedRect S; S.so.init(M, 2 * FF); S.A = (const char*)XB; S.B = (const char*)W1T; S.at = (size_t)256 * D * 2; S.bt = (size_t)256 * D * 2; S.G = G; S.c = c;
        pg8::EpiSwiglu E{HID, SSQ};
        pg8::gemm_phase(lds, D, D, D, S, E);
    }
    SEAM(1);
    if (IN(2)) {
        pg8::SchedRect S; S.so.init(M, D); S.A = (const char*)HID; S.B = (const char*)WD1T; S.at = (size_t)256 * FF * 2; S.bt = (size_t)256 * FF * 2; S.G = G; S.c = c;
        pg8::EpiResid E{x, out, XB, SSQ, 0.5f};
        pg8::gemm_phase(lds, FF, FF, FF, S, E);
    }
    SEAM(2);
    if (IN(3)) {
        pg8::SchedP3 S; S.so.init(M, INW); S.A = (const char*)XB; S.B = (const char*)WMIX; S.at = (size_t)256 * D * 2; S.bt = (size_t)256 * D * 2; S.G = G; S.c = c;
        pg8::EpiProj E{PROJ, MKV, SSQ};
        pg8::gemm_phase(lds, D, D, D, S, E);
    }
    SEAM(3);
    if (IN(4)) {
        const AttnArgs A{PROJ, MKV, ATT, na_rpb, lq1, lk1, lq2, lk2, subln};
        attention_phase(A, (LAS char*)lds, c, G);
    }
    SEAM(4);
    if (IN(5)) {
        pg8::SchedRect S; S.so.init(M, GW); S.A = (const char*)XB; S.B = (const char*)(WMIX + (size_t)INW * D); S.at = (size_t)256 * D * 2; S.bt = (size_t)256 * D * 2; S.G = G; S.c = c;
        pg8::EpiGate E{GATES, SSQ, b_gate};
        pg8::gemm_phase(lds, D, D, D, S, E);
    }
    SEAM(5);
    if (IN(6)) {
        pg8::SchedBr S; S.so.init(M, D); S.A = (const char*)ATT; S.B = (const char*)WBR; S.at = (size_t)256 * ATTW * 2; S.bt = (size_t)256 * 512 * 2; S.G = G; S.c = c;
        pg8::EpiMerge E{XB, GATES};
        pg8::gemm_phase(lds, 512, ATTW, 512, S, E);
    }
    SEAM(6);
    if (IN(7)) {
        pg8::SchedRect S; S.so.init(M, D); S.A = (const char*)XB; S.B = (const char*)WOUT; S.at = (size_t)256 * D * 2; S.bt = (size_t)256 * D * 2; S.G = G; S.c = c;
        pg8::EpiResid E{out, out, X2B, SSQ, 1.0f};
        pg8::gemm_phase(lds, D, D, D, S, E);
    }
    SEAM(7);
    if (IN(8)) {
        pg8::SchedRect S; S.so.init(M, 2 * FF); S.A = (const char*)X2B; S.B = (const char*)W2T; S.at = (size_t)256 * D * 2; S.bt = (size_t)256 * D * 2; S.G = G; S.c = c;
        pg8::EpiSwiglu E{HID, SSQ};
        pg8::gemm_phase(lds, D, D, D, S, E);
    }
    SEAM(8);
    if (IN(9)) {
        pg8::SchedRect S; S.so.init(M, D); S.A = (const char*)HID; S.B = (const char*)WD2T; S.at = (size_t)256 * FF * 2; S.bt = (size_t)256 * FF * 2; S.G = G; S.c = c;
        pg8::EpiResid E{out, out, nullptr, SSQ, 0.5f};
        pg8::gemm_phase(lds, FF, FF, FF, S, E);
    }
    SEAM(9);
    if (IN(10)) {
        const int gw = c * NWAVES + wave, ngw = G * NWAVES;
        f32x4 gn[4];
#pragma unroll
        for (int j = 0; j < 4; ++j) gn[j] = ((const f32x4*)final_norm)[lane + 64 * j];
        for (int r = gw; r < M; r += ngw) {
            const float rs = row_rstd(SSQ, r); f32x4* p = (f32x4*)(out + (size_t)r * D) + lane;
#pragma unroll
            for (int j = 0; j < 4; ++j) p[64 * j] = p[64 * j] * rs * gn[j];
        }
    }
#undef IN
#undef SEAM
}

extern "C" void kernel_launch(void* const* d_in, const int* in_sizes, int n_in, void* d_out, int out_size, void* d_ws, size_t ws_size, hipStream_t stream) {
    static int grid = 0;
    if (grid == 0) {
        if (n_in != 27 || out_size != M * D || ws_size < WS_END) { fprintf(stderr, "kernel_launch: unexpected problem (n_in %d out %d ws %zu)\n", n_in, out_size, ws_size); grid = -1; return; }
        int dev = 0, cus = 0, per_cu = 0;
        hipGetDevice(&dev); hipDeviceGetAttribute(&cus, hipDeviceAttributeMultiprocessorCount, dev);
        hipFuncSetAttribute((const void*)fwd_megakernel, hipFuncAttributeMaxDynamicSharedMemorySize, LDS_BYTES);
        if (hipOccupancyMaxActiveBlocksPerMultiprocessor(&per_cu, (const void*)fwd_megakernel, NTHR, LDS_BYTES) != hipSuccess || per_cu < 1) { fprintf(stderr, "kernel_launch: occupancy query says %d\n", per_cu); per_cu = 1; }
        (void)hipGetLastError();
        grid = cus * (per_cu > 1 ? 1 : per_cu);
    }
    if (grid < 0) return;
    Args a{};
    for (int i = 0; i < 27; ++i) a.in[i] = (const float*)d_in[i];
    a.out = (float*)d_out; a.ws = (unsigned char*)d_ws;
    if (MK_N_LAUNCHES == 1) {
        a.ph_lo = 0; a.ph_hi = 11; a.coop = 1;
        void* args[] = {&a};
        hipError_t e = hipLaunchCooperativeKernel((const void*)fwd_megakernel, dim3(grid), dim3(NTHR), args, LDS_BYTES, stream);
        if (e != hipSuccess) fprintf(stderr, "cooperative launch failed: %s (grid %d)\n", hipGetErrorString(e), grid);
    } else {
        for (int p = 0; p < 11; ++p) { a.ph_lo = p; a.ph_hi = p + 1; a.coop = 0; hipLaunchKernelGGL(fwd_megakernel, dim3(grid), dim3(NTHR), LDS_BYTES, stream, a); }
    }
}
```

```cpp
#include <hip/hip_runtime.h>
#include <hip/hip_cooperative_groups.h>
#include <cstdio>
#include <cstdint>
namespace cg = cooperative_groups;

#ifndef MK_N_LAUNCHES
#define MK_N_LAUNCHES 1
#endif

#ifndef PROBE_DUP
#define PROBE_DUP 0
#endif
#ifndef PROBE_SYNCS
#define PROBE_SYNCS 0
#endif
#define DUPF(k) (1 + ((PROBE_DUP >> (k)) & 1))

#define LAS __attribute__((address_space(3)))
#define DEV __device__ __forceinline__
typedef unsigned short bf16_t;
typedef short bf16x8 __attribute__((ext_vector_type(8)));
typedef short s16x4 __attribute__((ext_vector_type(4)));
typedef float f32x2 __attribute__((ext_vector_type(2)));
typedef float f32x4 __attribute__((ext_vector_type(4)));
typedef float f32x16 __attribute__((ext_vector_type(16)));
typedef unsigned u32x2 __attribute__((ext_vector_type(2)));
typedef unsigned u32x4 __attribute__((ext_vector_type(4)));
typedef __bf16 bf16x2_t __attribute__((ext_vector_type(2)));

constexpr int M = 16384, D = 1024, FF = 2816, INW = 3584, GW = 3072, SEQ = 2048, NB = 8, MEMT = 256, MEMR = NB * MEMT;
constexpr int O_NQ = 0, O_NK = 512, O_NV = 1024, O_DQ = 1536, O_DK = 2048, O_DV = 2560, O_MQ = 3072;
constexpr int ATTW = 1536;
constexpr float EPS = 1e-6f, LOG2E = 1.4426950408889634f;
constexpr int NTHR = 512, NWAVES = 8;
constexpr int LDS_BYTES = 147456, LDS_MISC = LDS_BYTES - 64;

constexpr size_t MiB = 1u << 20;
constexpr size_t WS_W1T = 0, WS_WD1T = 11 * MiB, WS_WMIX = WS_WD1T + 11 * MiB / 2, WS_WBR = WS_WMIX + 15 * MiB, WS_WOUT = WS_WBR + 3 * MiB,
                 WS_W2T = WS_WOUT + 2 * MiB, WS_WD2T = WS_W2T + 11 * MiB, WS_XB = 53 * MiB, WS_SSQ = 89 * MiB, WS_MKV = 91 * MiB, WS_OV = 96 * MiB;
constexpr size_t WS_CTL = 95 * MiB, CTL_BYTES = 16384;
constexpr size_t WS_HID = WS_OV, WS_PROJ = WS_OV, WS_GATES = WS_OV, WS_ATT = 208 * MiB, WS_X2B = 208 * MiB, WS_END = 256 * MiB;
static_assert(WS_WD2T + 11 * MiB / 2 == WS_XB, "weights end at 53 MiB");
static_assert(WS_PROJ + (size_t)M * INW * 2 == WS_ATT && WS_ATT + (size_t)M * ATTW * 2 == WS_END, "overlay map");

DEV unsigned cvtpk(float lo, float hi) { f32x2 v = {lo, hi}; bf16x2_t b = __builtin_convertvector(v, bf16x2_t); return __builtin_bit_cast(unsigned, b); }
DEV float bf_lo(unsigned w) { return __uint_as_float(w << 16); }
DEV float bf_hi(unsigned w) { return __uint_as_float(w & 0xffff0000u); }
DEV float wave_sum(float v) {
#pragma unroll
    for (int o = 1; o < 64; o <<= 1) v += __shfl_xor(v, o);
    return v;
}
DEV float row_rstd(const float* ssq, int row) {
    const f32x4* p = (const f32x4*)(ssq + (size_t)row * 16);
    const f32x4 a = p[0], b = p[1], c = p[2], d = p[3];
    const float s = ((a[0] + a[1]) + (a[2] + a[3])) + ((b[0] + b[1]) + (b[2] + b[3])) + ((c[0] + c[1]) + (c[2] + c[3])) + ((d[0] + d[1]) + (d[2] + d[3]));
    return __builtin_amdgcn_rsqf(s * (1.0f / D) + EPS);
}

namespace pg8 {
constexpr int BM = 256, BK = 64, HALF = 128, HTB = HALF * BK * 2, STAGE_BYTES = 8 * HTB, NXCD = 8, WGM = 8;
__host__ __device__ __forceinline__ int lds_byte(int r, int c) { const int st = (r >> 4) * 2 + (c >> 5), rr = r & 15, cc = c & 31, ob = rr * 64 + cc * 2; return st * 1024 + (ob ^ (((ob >> 9) & 1) << 5)); }
__host__ __device__ __forceinline__ void stage_rc(int b, int& R, int& C) { const int st = b / 1024, sb = b % 1024, swz = sb ^ (((sb >> 9) & 1) << 5); R = (st >> 1) * 16 + swz / 64; C = (st & 1) * 32 + (swz % 64) / 2; }
__host__ __device__ __forceinline__ int perm32(int rho) { const int n = rho >> 4, i = rho & 15; return 8 * (i >> 2) + 4 * n + (i & 3); }

struct Unit { int pm, pn, br; };

struct StaticOrder {
    int nM, nN, nwg;
    __device__ void init(int M_, int N_) { nM = M_ / BM; nN = N_ / BM; nwg = nM * nN; }
    __device__ void map(int L, Unit& u) const {
        int wgid = L; { const int q = nwg / NXCD, r = nwg % NXCD, xcd = wgid % NXCD, off = wgid / NXCD; wgid = (xcd < r ? xcd * (q + 1) : r * (q + 1) + (xcd - r) * q) + off; }
        const int nig = WGM * nN, gid = wgid / nig, fm = gid * WGM, gsz = (nM - fm) < WGM ? (nM - fm) : WGM;
        u.pm = fm + ((wgid % nig) % gsz); u.pn = (wgid % nig) / gsz; u.br = 0;
    }
};
struct SchedRect {
    StaticOrder so; const char* A; const char* B; size_t at, bt; int G, c, dup;
    DEV bool next(int i, Unit& u) const { int L = i * G + c; if (L >= dup * so.nwg) return false; if (L >= so.nwg) L -= so.nwg; so.map(L, u); return true; }
    DEV const char* aptr(const Unit& u) const { return A + (size_t)u.pm * at; }
    DEV const char* bptr(const Unit& u) const { return B + (size_t)u.pn * bt; }
};
struct SchedP3 {
    StaticOrder so; const char* A; const char* B; size_t at, bt; int G, c, dup;
    DEV bool next(int i, Unit& u) const {
        int L = i * G + c; if (dup > 1 && L >= so.nwg + 32) L -= so.nwg + 32;
        if (L < so.nwg) { so.map(L, u); return true; }
        const int e = L - so.nwg; if (e >= 32) return false;
        u.pm = 64 + (e >> 2); u.pn = 26 + (e & 3); u.br = 0; return true;
    }
    DEV const char* aptr(const Unit& u) const { return A + (size_t)u.pm * at; }
    DEV const char* bptr(const Unit& u) const { return B + (size_t)u.pn * bt; }
};
struct SchedBr {
    StaticOrder so; const char* A; const char* B; size_t at, bt; int G, c, dup;
    DEV bool next(int i, Unit& u) const { int L = (i / 3) * G + c; if (L >= dup * so.nwg) return false; if (L >= so.nwg) L -= so.nwg; so.map(L, u); u.br = i % 3; return true; }
    DEV const char* aptr(const Unit& u) const { return A + (size_t)u.pm * at + (size_t)u.br * 512 * 2; }
    DEV const char* bptr(const Unit& u) const { return B + ((size_t)u.br * 4 + u.pn) * bt; }
};

typedef f32x4 Acc[2][2][4][2];

DEV float silu_mul(float g, float u) { return g * u * __builtin_amdgcn_rcpf(1.0f + __builtin_amdgcn_exp2f(-LOG2E * g)); }
DEV float sigm(float v) { return __builtin_amdgcn_rcpf(1.0f + __builtin_amdgcn_exp2f(-LOG2E * v)); }

struct EpiSwiglu {
    static constexpr bool PERM = true;
    bf16_t* H; const float* ssq;
    DEV void operator()(const Acc& acc, const Unit& u, int wr, int wc, int fr, int fq) const {
        const int row0 = u.pm * BM + wr * 64 + fr, col0 = u.pn * 128 + wc * 32 + 8 * fq;
#pragma unroll
        for (int ai = 0; ai < 2; ++ai)
#pragma unroll
            for (int m = 0; m < 4; ++m) {
                const int row = row0 + ai * HALF + m * 16; const float rs = row_rstd(ssq, row);
                const f32x4 g0 = acc[ai][0][m][0] * rs, g1 = acc[ai][0][m][1] * rs, u0 = acc[ai][1][m][0] * rs, u1 = acc[ai][1][m][1] * rs;
                u32x4 w;
                w.x = cvtpk(silu_mul(g0[0], u0[0]), silu_mul(g0[1], u0[1])); w.y = cvtpk(silu_mul(g0[2], u0[2]), silu_mul(g0[3], u0[3]));
                w.z = cvtpk(silu_mul(g1[0], u1[0]), silu_mul(g1[1], u1[1])); w.w = cvtpk(silu_mul(g1[2], u1[2]), silu_mul(g1[3], u1[3]));
                *(u32x4*)(H + (size_t)row * FF + col0) = w;
            }
    }
};
struct EpiResid {
    static constexpr bool PERM = false;
    const float* base; float* out; bf16_t* xb; float* ssq; float s;
    DEV void operator()(const Acc& acc, const Unit& u, int wr, int wc, int fr, int fq) const {
        const int row0 = u.pm * BM + wr * 64 + fr, col0 = u.pn * BM + wc * 32 + 4 * fq;
#pragma unroll
        for (int ai = 0; ai < 2; ++ai)
#pragma unroll
            for (int m = 0; m < 4; ++m) {
                const int row = row0 + ai * HALF + m * 16; const size_t off = (size_t)row * D + col0; float q = 0.f;
#pragma unroll
                for (int bj = 0; bj < 2; ++bj)
#pragma unroll
                    for (int n = 0; n < 2; ++n) {
                        const f32x4 b = *(const f32x4*)(base + off + bj * HALF + n * 16);
                        const f32x4 v = b + acc[ai][bj][m][n] * s;
                        *(f32x4*)(out + off + bj * HALF + n * 16) = v;
                        if (xb) { u32x2 w; w.x = cvtpk(v[0], v[1]); w.y = cvtpk(v[2], v[3]); *(u32x2*)(xb + off + bj * HALF + n * 16) = w; }
                        q += (v[0] * v[0] + v[1] * v[1]) + (v[2] * v[2] + v[3] * v[3]);
                    }
                q += __shfl_xor(q, 16); q += __shfl_xor(q, 32);
                if (fq == 0) ssq[(size_t)row * 16 + u.pn * 4 + wc] = q;
                asm volatile("" ::: "memory");
            }
    }
};
struct EpiProj {
    static constexpr bool PERM = true;
    bf16_t* P; bf16_t* MKV; const float* ssq;
    DEV void operator()(const Acc& acc, const Unit& u, int wr, int wc, int fr, int fq) const {
        const int row0 = u.pm * BM + wr * 64 + fr; const bool mem = u.pm >= 64;
        bf16_t* base = mem ? MKV + (size_t)(row0 - M) * 1024 + (u.pn - 26) * BM : P + (size_t)row0 * INW + u.pn * BM;
        const size_t ldc = mem ? 1024 : INW; base += wc * 32 + 8 * fq;
#pragma unroll
        for (int ai = 0; ai < 2; ++ai)
#pragma unroll
            for (int m = 0; m < 4; ++m) {
                const int row = row0 + ai * HALF + m * 16; const float rs = row_rstd(ssq, row);
                bf16_t* rp = base + (size_t)(ai * HALF + m * 16) * ldc;
#pragma unroll
                for (int bj = 0; bj < 2; ++bj) {
                    const f32x4 v0 = acc[ai][bj][m][0] * rs, v1 = acc[ai][bj][m][1] * rs; u32x4 w;
                    w.x = cvtpk(v0[0], v0[1]); w.y = cvtpk(v0[2], v0[3]); w.z = cvtpk(v1[0], v1[1]); w.w = cvtpk(v1[2], v1[3]);
                    *(u32x4*)(rp + bj * HALF) = w;
                }
            }
    }
};
struct EpiGate {
    static constexpr bool PERM = true;
    bf16_t* Gt; const float* ssq; const float* bias;
    DEV void operator()(const Acc& acc, const Unit& u, int wr, int wc, int fr, int fq) const {
        const int row0 = u.pm * BM + wr * 64 + fr, col0 = u.pn * BM + wc * 32 + 8 * fq;
        f32x4 bv[2][2];
#pragma unroll
        for (int bj = 0; bj < 2; ++bj)
#pragma unroll
            for (int n = 0; n < 2; ++n) bv[bj][n] = *(const f32x4*)(bias + col0 + bj * HALF + 4 * n);
#pragma unroll
        for (int ai = 0; ai < 2; ++ai)
#pragma unroll
            for (int m = 0; m < 4; ++m) {
                const int row = row0 + ai * HALF + m * 16; const float rs = row_rstd(ssq, row);
#pragma unroll
                for (int bj = 0; bj < 2; ++bj) {
                    const f32x4 v0 = acc[ai][bj][m][0] * rs + bv[bj][0], v1 = acc[ai][bj][m][1] * rs + bv[bj][1]; u32x4 w;
                    w.x = cvtpk(sigm(v0[0]), sigm(v0[1])); w.y = cvtpk(sigm(v0[2]), sigm(v0[3])); w.z = cvtpk(sigm(v1[0]), sigm(v1[1])); w.w = cvtpk(sigm(v1[2]), sigm(v1[3]));
                    *(u32x4*)(Gt + (size_t)row * GW + col0 + bj * HALF) = w;
                }
            }
    }
};
struct EpiMerge {
    static constexpr bool PERM = true;
    bf16_t* Mg; const bf16_t* Gt;
    DEV void operator()(const Acc& acc, const Unit& u, int wr, int wc, int fr, int fq) const {
        const int row0 = u.pm * BM + wr * 64 + fr, col0 = u.pn * BM + wc * 32 + 8 * fq;
#pragma unroll
        for (int ai = 0; ai < 2; ++ai)
#pragma unroll
            for (int m = 0; m < 4; ++m) {
                const int row = row0 + ai * HALF + m * 16;
#pragma unroll
                for (int bj = 0; bj < 2; ++bj) {
                    const u32x4 g = *(const u32x4*)(Gt + (size_t)row * GW + u.br * D + col0 + bj * HALF);
                    bf16_t* mp = Mg + (size_t)row * D + col0 + bj * HALF;
                    const f32x4 a0 = acc[ai][bj][m][0], a1 = acc[ai][bj][m][1];
                    float v[8] = {bf_lo(g.x) * a0[0], bf_hi(g.x) * a0[1], bf_lo(g.y) * a0[2], bf_hi(g.y) * a0[3], bf_lo(g.z) * a1[0], bf_hi(g.z) * a1[1], bf_lo(g.w) * a1[2], bf_hi(g.w) * a1[3]};
                    if (u.br != 0) { const u32x4 o = *(const u32x4*)mp;
                        v[0] += bf_lo(o.x); v[1] += bf_hi(o.x); v[2] += bf_lo(o.y); v[3] += bf_hi(o.y); v[4] += bf_lo(o.z); v[5] += bf_hi(o.z); v[6] += bf_lo(o.w); v[7] += bf_hi(o.w); }
                    u32x4 w; w.x = cvtpk(v[0], v[1]); w.y = cvtpk(v[2], v[3]); w.z = cvtpk(v[4], v[5]); w.w = cvtpk(v[6], v[7]);
                    *(u32x4*)mp = w;
                }
            }
        asm volatile("s_waitcnt vmcnt(0)" ::: "memory");
    }
};

template <class Epi, class Sched>
DEV void gemm_phase(LAS unsigned char* lds, const int K, const int lda, const int ldb, const Sched& S, const Epi& E) {
    const int tid = threadIdx.x, wid = __builtin_amdgcn_readfirstlane(tid >> 6), lane = tid & 63, wr = wid >> 2, wc = wid & 3, fr = lane & 15, fq = lane >> 4;
    const int nt = K / BK;
    unsigned voffA[2], voffB[2];
#pragma unroll
    for (int i = 0; i < 2; ++i) { int R, C; stage_rc(tid * 16 + i * 8192, R, C); const int Rb = Epi::PERM ? ((R & ~31) + perm32(R & 31)) : R;
        voffA[i] = (unsigned)(R * lda + C) * 2u; voffB[i] = (unsigned)(Rb * ldb + C) * 2u; }
    const size_t kstep = (size_t)(BK * 2);
    const size_t hstepA = (size_t)HALF * lda * 2, hstepB = (size_t)HALF * ldb * 2;
    const unsigned ldsw = (unsigned)wid * 1024u;
    const int aoff = lds_byte(wr * 64 + fr, fq * 8), boff = lds_byte(wc * 32 + fr, fq * 8);
#define PG8_SA(b, h) (((b) * 2 + (h)) * HTB)
#define PG8_SB(b, h) ((4 + (b) * 2 + (h)) * HTB)
#define PG8_STAGE(bufoff, gbase, voff) do { _Pragma("unroll") for (int _i = 0; _i < 2; ++_i) \
        __builtin_amdgcn_global_load_lds((const unsigned*)((const char*)(gbase) + (voff)[_i]), (LAS unsigned*)(lds + (bufoff) + ldsw + _i * 8192), 16, 0, 0); } while (0)
#define PG8_LDA(dst, b, h) do { _Pragma("unroll") for (int m = 0; m < 4; ++m) _Pragma("unroll") for (int k = 0; k < 2; ++k) dst[m][k] = *(const LAS bf16x8*)(lds + PG8_SA(b, h) + aoff + m * 2048 + k * 1024); } while (0)
#define PG8_LDB(dst, b, h) do { _Pragma("unroll") for (int n = 0; n < 2; ++n) _Pragma("unroll") for (int k = 0; k < 2; ++k) dst[n][k] = *(const LAS bf16x8*)(lds + PG8_SB(b, h) + boff + n * 2048 + k * 1024); } while (0)
#define PG8_MMA(ai, bj, At, Bt) do { __builtin_amdgcn_s_setprio(1); _Pragma("unroll") for (int m = 0; m < 4; ++m) _Pragma("unroll") for (int n = 0; n < 2; ++n) _Pragma("unroll") for (int k = 0; k < 2; ++k) \
        acc[ai][bj][m][n] = __builtin_amdgcn_mfma_f32_16x16x32_bf16(Bt[n][k], At[m][k], acc[ai][bj][m][n], 0, 0, 0); __builtin_amdgcn_s_setprio(0); } while (0)
#define PG8_WAIT_V(n) asm volatile("s_waitcnt vmcnt(" #n ")" ::: "memory")
#define PG8_WAIT_L(n) asm volatile("s_waitcnt lgkmcnt(" #n ")" ::: "memory")
#define PG8_BAR __builtin_amdgcn_s_barrier()
#define PG8_SCHED __builtin_amdgcn_sched_barrier(0)
    Unit cur, nxt; int ui = 0;
    if (!S.next(0, cur)) return;
    Acc acc;
#pragma unroll
    for (int a = 0; a < 2; ++a)
#pragma unroll
        for (int b = 0; b < 2; ++b)
#pragma unroll
            for (int m = 0; m < 4; ++m)
#pragma unroll
                for (int n = 0; n < 2; ++n) acc[a][b][m][n] = (f32x4){0.f, 0.f, 0.f, 0.f};
    bf16x8 At[4][2], B0[2][2], B1[2][2];
    const char* cA = S.aptr(cur); const char* cB = S.bptr(cur);
    PG8_STAGE(PG8_SB(0, 0), cB, voffB); PG8_STAGE(PG8_SB(0, 1), cB + hstepB, voffB); PG8_STAGE(PG8_SA(0, 0), cA, voffA); PG8_STAGE(PG8_SA(0, 1), cA + hstepA, voffA);
    if (wr == 1) PG8_BAR;
    PG8_WAIT_V(2); PG8_BAR;
    PG8_STAGE(PG8_SB(1, 0), cB + kstep, voffB); PG8_STAGE(PG8_SA(1, 0), cA + kstep, voffA); PG8_STAGE(PG8_SB(1, 1), cB + hstepB + kstep, voffB);
    PG8_WAIT_V(6); PG8_BAR;
    for (;;) {
        const bool has_next = S.next(ui + 1, nxt);
        const char* nA = has_next ? S.aptr(nxt) : cA; const char* nB = has_next ? S.bptr(nxt) : cB;
        for (int t = 0; t < nt; t += 2) {
            const bool last = (t == nt - 2);
            const char* a1 = cA + (size_t)(t + 1) * kstep;
            const char* a2 = last ? nA : cA + (size_t)(t + 2) * kstep; const char* b2 = last ? nB : cB + (size_t)(t + 2) * kstep;
            const char* a3 = a2 + kstep; const char* b3 = b2 + kstep;
            PG8_LDB(B0, 0, 0); PG8_LDB(B1, 0, 1); PG8_SCHED; PG8_LDA(At, 0, 0); PG8_STAGE(PG8_SA(1, 1), a1 + hstepA, voffA);
            PG8_WAIT_V(8); PG8_WAIT_L(0); PG8_BAR; PG8_MMA(0, 0, At, B0); PG8_MMA(0, 1, At, B1); PG8_BAR; PG8_SCHED;
            PG8_LDA(At, 0, 1); PG8_STAGE(PG8_SB(0, 0), b2, voffB); PG8_STAGE(PG8_SB(0, 1), b2 + hstepB, voffB); PG8_STAGE(PG8_SA(0, 0), a2, voffA);
            PG8_WAIT_V(8); PG8_WAIT_L(0); PG8_BAR; PG8_MMA(1, 0, At, B0); PG8_MMA(1, 1, At, B1); PG8_BAR; PG8_SCHED;
            PG8_LDB(B0, 1, 0); PG8_LDB(B1, 1, 1); PG8_SCHED; PG8_LDA(At, 1, 0); PG8_STAGE(PG8_SA(0, 1), a2 + hstepA, voffA);
            PG8_WAIT_V(8); PG8_WAIT_L(0); PG8_BAR; PG8_MMA(0, 0, At, B0); PG8_MMA(0, 1, At, B1); PG8_BAR; PG8_SCHED;
            PG8_LDA(At, 1, 1); PG8_STAGE(PG8_SB(1, 0), b3, voffB); PG8_STAGE(PG8_SB(1, 1), b3 + hstepB, voffB); PG8_STAGE(PG8_SA(1, 0), a3, voffA);
            PG8_WAIT_V(8); PG8_WAIT_L(0); PG8_BAR; PG8_MMA(1, 0, At, B0); PG8_MMA(1, 1, At, B1); PG8_BAR; PG8_SCHED;
        }
        if (wr == 0) PG8_BAR;
        E(acc, cur, wr, wc, fr, fq);
        if (!has_next) break;
#pragma unroll
        for (int a = 0; a < 2; ++a)
#pragma unroll
            for (int b = 0; b < 2; ++b)
#pragma unroll
                for (int m = 0; m < 4; ++m)
#pragma unroll
                    for (int n = 0; n < 2; ++n) acc[a][b][m][n] = (f32x4){0.f, 0.f, 0.f, 0.f};
        cur = nxt; cA = nA; cB = nB; ++ui;
        if (wr == 1) PG8_BAR;
    }
    PG8_WAIT_V(0);
    PG8_BAR;
#undef PG8_SA
#undef PG8_SB
#undef PG8_STAGE
#undef PG8_LDA
#undef PG8_LDB
#undef PG8_MMA
#undef PG8_WAIT_V
#undef PG8_WAIT_L
#undef PG8_BAR
#undef PG8_SCHED
}
}

DEV void transpose_item(const float* W, int K, int N, bf16_t* WT, int k0, int n0, int dst_row0, const float* gain, LAS float* scr, int lane) {
#pragma unroll 8
    for (int i = 0; i < 32; ++i) { const int kk = 2 * i + (lane >> 5); float v = W[(size_t)(k0 + kk) * N + n0 + (lane & 31)]; if (gain) v *= gain[k0 + kk]; scr[kk * 33 + (lane & 31)] = v; }
    asm volatile("s_waitcnt lgkmcnt(0)" ::: "memory");
    const int c = lane & 7;
#pragma unroll
    for (int j = 0; j < 4; ++j) { const int n = (lane >> 3) + 8 * j; const LAS float* s = scr + (8 * c) * 33 + n;
        u32x4 o; o.x = cvtpk(s[0 * 33], s[1 * 33]); o.y = cvtpk(s[2 * 33], s[3 * 33]); o.z = cvtpk(s[4 * 33], s[5 * 33]); o.w = cvtpk(s[6 * 33], s[7 * 33]);
        *(u32x4*)(WT + (size_t)(dst_row0 + n) * K + k0 + 8 * c) = o; }
    asm volatile("s_waitcnt lgkmcnt(0)" ::: "memory");
}
template <int MODE>
DEV void transpose_matrix(const float* W, int K, int N, bf16_t* WT, int row_off, const float* gain, LAS float* scr, int gw, int ngw, int lane) {
    const int nblk = N / 32, nitems = (K / 64) * nblk;
    for (int it0 = gw; it0 < DUPF(0) * nitems; it0 += ngw) {
        const int it = it0 >= nitems ? it0 - nitems : it0;
        const int kb = it / nblk, nb = it % nblk, n0 = 32 * nb;
        const int dr = MODE == 0 ? row_off + n0 : 256 * (n0 >> 7) + 128 * (MODE - 1) + (n0 & 127);
        transpose_item(W, K, N, WT, 64 * kb, n0, dr, gain, scr, lane);
    }
}
DEV void row_to_bf16(const float* xrow, bf16_t* orow, float* ssq_row, int lane) {
    const f32x4* xr = (const f32x4*)xrow + lane; f32x4 v[4]; float s = 0.f;
#pragma unroll
    for (int j = 0; j < 4; ++j) { v[j] = xr[64 * j]; s += (v[j][0] * v[j][0] + v[j][1] * v[j][1]) + (v[j][2] * v[j][2] + v[j][3] * v[j][3]); }
    s = wave_sum(s);
    u32x2* o8 = (u32x2*)orow + lane;
#pragma unroll
    for (int j = 0; j < 4; ++j) { u32x2 w; w.x = cvtpk(v[j][0], v[j][1]); w.y = cvtpk(v[j][2], v[j][3]); o8[64 * j] = w; }
    if (lane < 16) ssq_row[lane] = lane == 0 ? s : 0.f;
}

#define MFMA32(a, b, c) __builtin_amdgcn_mfma_f32_32x32x16_bf16((a), (b), (c), 0, 0, 0)
typedef short v4i16_t __attribute__((ext_vector_type(4)));
DEV s16x4 vtr(const LAS char* p) { return __builtin_bit_cast(s16x4, __builtin_amdgcn_ds_read_tr16_b64_v4i16((LAS v4i16_t*)p)); }
DEV int crow(int r, int hi) { return (r & 3) + 8 * (r >> 2) + 4 * hi; }
constexpr float NEG_BIG = -3.0e38f;

constexpr int ALDS_V = 0, ALDS_K = 36864, ALDS_X = 70656;
static_assert(ALDS_X + 65536 <= 131072 + 8192, "attention LDS");

template <int NCH> DEV void tile_gload(u32x4 (&st)[NCH / 8], const char* g, size_t gp, int tid) {
#pragma unroll
    for (int i = 0; i < NCH / 8; ++i) { const int c = tid + NTHR * i, row = c / NCH, ch = c % NCH; st[i] = *(const u32x4*)(g + (size_t)row * gp + ch * 16); }
}
template <int NCH, int PITCH> DEV void tile_swrite(const u32x4 (&st)[NCH / 8], LAS char* l, int tid) {
#pragma unroll
    for (int i = 0; i < NCH / 8; ++i) { const int c = tid + NTHR * i, row = c / NCH, ch = c % NCH; *(LAS u32x4*)(l + row * PITCH + ch * 16) = st[i]; }
}
template <int DK, int KP> DEV void qk_tile(f32x16& p0, f32x16& p1, const LAS char* Kt, const bf16x8 (&qf)[DK / 16], int r32, int hi) {
    const LAS char* ka = Kt + r32 * KP + hi * 16;
#pragma unroll
    for (int r = 0; r < 16; ++r) { p0[r] = 0.f; p1[r] = 0.f; }
#pragma unroll
    for (int ks = 0; ks < DK / 16; ++ks) {
        const bf16x8 a0 = *(const LAS bf16x8*)(ka + ks * 32), a1 = *(const LAS bf16x8*)(ka + 32 * KP + ks * 32);
        p0 = MFMA32(a0, qf[ks], p0); p1 = MFMA32(a1, qf[ks], p1);
    }
}
template <int DV, int VP> DEV void softmax_pv(f32x16& p0, f32x16& p1, f32x16 (&o)[DV / 32], float& m, float& l, const LAS char* Vt, int lane) {
    float mx = fmaxf(p0[0], p1[0]);
#pragma unroll
    for (int r = 1; r < 16; ++r) mx = fmaxf(mx, fmaxf(p0[r], p1[r]));
    mx = fmaxf(mx, __shfl_xor(mx, 32));
    const float mnew = fmaxf(m, mx), alpha = __builtin_amdgcn_exp2f(m - mnew);
    m = mnew; float s = 0.f;
#pragma unroll
    for (int r = 0; r < 16; ++r) { p0[r] = __builtin_amdgcn_exp2f(p0[r] - mnew); p1[r] = __builtin_amdgcn_exp2f(p1[r] - mnew); s += p0[r] + p1[r]; }
    l = l * alpha + s;
    if (__any(alpha != 1.0f)) {
#pragma unroll
        for (int d = 0; d < DV / 32; ++d)
#pragma unroll
            for (int r = 0; r < 16; ++r) o[d][r] *= alpha;
    }
    const int hi = lane >> 5;
    const LAS char* va = Vt + (4 * hi + ((lane & 15) >> 2)) * VP + (16 * ((lane >> 4) & 1) + 4 * (lane & 3)) * 2;
#pragma unroll
    for (int s4 = 0; s4 < 4; ++s4) {
        u32x4 pw;
        if (s4 == 0) { pw.x = cvtpk(p0[0], p0[1]); pw.y = cvtpk(p0[2], p0[3]); pw.z = cvtpk(p0[4], p0[5]); pw.w = cvtpk(p0[6], p0[7]); }
        else if (s4 == 1) { pw.x = cvtpk(p0[8], p0[9]); pw.y = cvtpk(p0[10], p0[11]); pw.z = cvtpk(p0[12], p0[13]); pw.w = cvtpk(p0[14], p0[15]); }
        else if (s4 == 2) { pw.x = cvtpk(p1[0], p1[1]); pw.y = cvtpk(p1[2], p1[3]); pw.z = cvtpk(p1[4], p1[5]); pw.w = cvtpk(p1[6], p1[7]); }
        else { pw.x = cvtpk(p1[8], p1[9]); pw.y = cvtpk(p1[10], p1[11]); pw.z = cvtpk(p1[12], p1[13]); pw.w = cvtpk(p1[14], p1[15]); }
        const bf16x8 pf = __builtin_bit_cast(bf16x8, pw);
#pragma unroll
        for (int d = 0; d < DV / 32; ++d) {
            const s16x4 lo = vtr(va + (16 * s4) * VP + d * 64), hh = vtr(va + (16 * s4 + 8) * VP + d * 64);
            const bf16x8 vf = __builtin_shufflevector(lo, hh, 0, 1, 2, 3, 4, 5, 6, 7);
            o[d] = MFMA32(vf, pf, o[d]);
        }
    }
}
template <int DV> DEV void store_ot(const f32x16 (&o)[DV / 32], float inv, bf16_t* orow, int hi) {
#pragma unroll
    for (int d = 0; d < DV / 32; ++d)
#pragma unroll
        for (int g = 0; g < 4; ++g) { u32x2 w; w.x = cvtpk(o[d][4 * g] * inv, o[d][4 * g + 1] * inv); w.y = cvtpk(o[d][4 * g + 2] * inv, o[d][4 * g + 3] * inv);
            *(u32x2*)(orow + 32 * d + 8 * g + 4 * hi) = w; }
}

struct AttnArgs { const bf16_t* proj; const bf16_t* mkv; bf16_t* att; const float* rpb; const float* lq1; const float* lk1; const float* lq2; const float* lk2; const float* subln; };

DEV void diff_unit(const AttnArgs& A, LAS char* lds, int b, int h, int qb, float lam) {
    constexpr int KP = 272, VP = 320, NT = SEQ / 64;
    const int tid = threadIdx.x, lane = tid & 63, r32 = lane & 31, hi = lane >> 5, wid = __builtin_amdgcn_readfirstlane(tid >> 6), map = wid >> 2;
    const size_t rowb = (size_t)b * SEQ; const int q0 = qb * 128 + (wid & 3) * 32;
    const bf16_t* qp = A.proj + (rowb + q0 + r32) * INW + O_DQ + h * 128 + map * 64 + hi * 8;
    bf16x8 qf[4];
#pragma unroll
    for (int ks = 0; ks < 4; ++ks) qf[ks] = *(const bf16x8*)(qp + ks * 16);
    const char* kg = (const char*)(A.proj + rowb * INW + O_DK + h * 128); const char* vg = (const char*)(A.proj + rowb * INW + O_DV + h * 128);
    const size_t gp = (size_t)INW * 2;
    f32x16 o[4];
#pragma unroll
    for (int d = 0; d < 4; ++d)
#pragma unroll
        for (int r = 0; r < 16; ++r) o[d][r] = 0.f;
    float m = -1.0e30f, l = 0.f;
    const float c2 = 0.125f * LOG2E, sl2 = exp2f(-2.0f * (float)(h + 1)) * LOG2E;
    const float qpos = (float)(q0 + r32 - 4 * hi);
    u32x4 ks_[2], vs_[2];
    tile_gload<16>(ks_, kg, gp, tid); tile_gload<16>(vs_, vg, gp, tid);
    for (int t = 0; t < NT; ++t) {
        __syncthreads();
        tile_swrite<16, KP>(ks_, lds + ALDS_K, tid); tile_swrite<16, VP>(vs_, lds + ALDS_V, tid);
        __syncthreads();
        if (t + 1 < NT) { tile_gload<16>(ks_, kg + (size_t)(t + 1) * 64 * gp, gp, tid); tile_gload<16>(vs_, vg + (size_t)(t + 1) * 64 * gp, gp, tid); }
        f32x16 p0, p1;
        qk_tile<64, KP>(p0, p1, lds + ALDS_K + map * 128, qf, r32, hi);
        const float dq = qpos - (float)(t * 64);
#pragma unroll
        for (int r = 0; r < 16; ++r) { const float kr = (float)((r & 3) + 8 * (r >> 2));
            p0[r] = p0[r] * c2 - sl2 * fabsf(dq - kr); p1[r] = p1[r] * c2 - sl2 * fabsf(dq - (kr + 32.f)); }
        softmax_pv<128, VP>(p0, p1, o, m, l, lds + ALDS_V, lane);
    }
    l += __shfl_xor(l, 32);
    const float inv = (map ? lam : 1.0f) / l;
    LAS f32x4* xch = (LAS f32x4*)(lds + ALDS_X + (wid & 3) * 16384) + lane;
    if (map) {
#pragma unroll
        for (int d = 0; d < 4; ++d)
#pragma unroll
            for (int g = 0; g < 4; ++g) xch[(d * 4 + g) * 64] = (f32x4){o[d][4 * g] * inv, o[d][4 * g + 1] * inv, o[d][4 * g + 2] * inv, o[d][4 * g + 3] * inv};
    }
    __syncthreads();
    if (!map) {
        float ss = 0.f;
#pragma unroll
        for (int d = 0; d < 4; ++d)
#pragma unroll
            for (int g = 0; g < 4; ++g) { const f32x4 x2 = xch[(d * 4 + g) * 64];
#pragma unroll
                for (int i = 0; i < 4; ++i) { const float v = o[d][4 * g + i] * inv - x2[i]; o[d][4 * g + i] = v; ss += v * v; } }
        ss += __shfl_xor(ss, 32);
        const float rn = __builtin_amdgcn_rsqf(ss * (1.0f / 128.0f) + EPS) * 0.8f;
        bf16_t* orow = A.att + (rowb + q0 + r32) * ATTW + 512 + h * 128;
#pragma unroll
        for (int d = 0; d < 4; ++d)
#pragma unroll
            for (int g = 0; g < 4; ++g) { const f32x4 sg = *(const f32x4*)(A.subln + 32 * d + 8 * g + 4 * hi); u32x2 w;
                w.x = cvtpk(o[d][4 * g] * rn * sg[0], o[d][4 * g + 1] * rn * sg[1]); w.y = cvtpk(o[d][4 * g + 2] * rn * sg[2], o[d][4 * g + 3] * rn * sg[3]);
                *(u32x2*)(orow + 32 * d + 8 * g + 4 * hi) = w; }
    }
}
DEV void na_unit(const AttnArgs& A, LAS char* lds, int b, int r, int hg) {
    constexpr int KP = 528, VP = 576;
    const int tid = threadIdx.x, lane = tid & 63, r32 = lane & 31, hi = lane >> 5, wid = __builtin_amdgcn_readfirstlane(tid >> 6), hh = wid >> 1, head = hg * 4 + hh;
    const size_t rowb = (size_t)b * SEQ; const int c = (wid & 1) * 32 + r32;
    const bf16_t* qp = A.proj + (rowb + r * 64 + c) * INW + O_NQ + head * 64 + hi * 8;
    bf16x8 qf[4];
#pragma unroll
    for (int ks = 0; ks < 4; ++ks) qf[ks] = *(const bf16x8*)(qp + ks * 16);
    const int rs = min(max(r - 4, 0), 24), cs = min(max(c - 8, 0), 48);
    const char* kg = (const char*)(A.proj + (rowb + rs * 64) * INW + O_NK + hg * 256); const char* vg = (const char*)(A.proj + (rowb + rs * 64) * INW + O_NV + hg * 256);
    const size_t gp = (size_t)INW * 2;
    const LAS float* tab = (const LAS float*)(lds + ALDS_X) + head * 465;
    f32x16 o[2];
#pragma unroll
    for (int d = 0; d < 2; ++d)
#pragma unroll
        for (int rr = 0; rr < 16; ++rr) o[d][rr] = 0.f;
    float m = -1.0e30f, l = 0.f; const float c2 = 0.125f * LOG2E;
    u32x4 ks_[4], vs_[4];
    tile_gload<32>(ks_, kg, gp, tid); tile_gload<32>(vs_, vg, gp, tid);
    for (int j = 0; j < 8; ++j) {
        __syncthreads();
        tile_swrite<32, KP>(ks_, lds + ALDS_K, tid); tile_swrite<32, VP>(vs_, lds + ALDS_V, tid);
        __syncthreads();
        if (j + 1 < 8) { tile_gload<32>(ks_, kg + (size_t)(j + 1) * 64 * gp, gp, tid); tile_gload<32>(vs_, vg + (size_t)(j + 1) * 64 * gp, gp, tid); }
        f32x16 p0, p1;
        qk_tile<64, KP>(p0, p1, lds + ALDS_K + hh * 128, qf, r32, hi);
        const int dr = rs + j - r + 7; const LAS float* trow = tab + dr * 31 + 15 - c;
#pragma unroll
        for (int rr = 0; rr < 16; ++rr) {
            const int kc0 = crow(rr, hi), kc1 = kc0 + 32;
            const bool v0 = (unsigned)(kc0 - cs) < 16u, v1 = (unsigned)(kc1 - cs) < 16u;
            const float b0 = trow[v0 ? kc0 : c], b1 = trow[v1 ? kc1 : c];
            p0[rr] = v0 ? p0[rr] * c2 + b0 : NEG_BIG; p1[rr] = v1 ? p1[rr] * c2 + b1 : NEG_BIG;
        }
        softmax_pv<64, VP>(p0, p1, o, m, l, lds + ALDS_V + hh * 128, lane);
    }
    l += __shfl_xor(l, 32);
    store_ot<64>(o, 1.0f / l, A.att + (rowb + r * 64 + c) * ATTW + head * 64, hi);
}
DEV void mem_unit(const AttnArgs& A, LAS char* lds, int b, int h, int qb) {
    constexpr int KP = 272, VP = 320;
    const int tid = threadIdx.x, lane = tid & 63, r32 = lane & 31, hi = lane >> 5, wid = __builtin_amdgcn_readfirstlane(tid >> 6);
    const size_t row = (size_t)b * SEQ + qb * 256 + wid * 32 + r32;
    const bf16_t* qp = A.proj + row * INW + O_MQ + h * 128 + hi * 8;
    bf16x8 qf[8];
#pragma unroll
    for (int ks = 0; ks < 8; ++ks) qf[ks] = *(const bf16x8*)(qp + ks * 16);
    const char* kg = (const char*)(A.mkv + (size_t)b * MEMT * 1024 + h * 128); const char* vg = kg + 512 * 2;
    const size_t gp = 1024 * 2;
    f32x16 o[4];
#pragma unroll
    for (int d = 0; d < 4; ++d)
#pragma unroll
        for (int rr = 0; rr < 16; ++rr) o[d][rr] = 0.f;
    float m = -1.0e30f, l = 0.f; const float c2 = 0.08838834764831845f * LOG2E;
    u32x4 ks_[2], vs_[2];
    tile_gload<16>(ks_, kg, gp, tid); tile_gload<16>(vs_, vg, gp, tid);
    for (int t = 0; t < 4; ++t) {
        __syncthreads();
        tile_swrite<16, KP>(ks_, lds + ALDS_K, tid); tile_swrite<16, VP>(vs_, lds + ALDS_V, tid);
        __syncthreads();
        if (t + 1 < 4) { tile_gload<16>(ks_, kg + (size_t)(t + 1) * 64 * gp, gp, tid); tile_gload<16>(vs_, vg + (size_t)(t + 1) * 64 * gp, gp, tid); }
        f32x16 p0, p1;
        qk_tile<128, KP>(p0, p1, lds + ALDS_K, qf, r32, hi);
#pragma unroll
        for (int rr = 0; rr < 16; ++rr) { p0[rr] *= c2; p1[rr] *= c2; }
        softmax_pv<128, VP>(p0, p1, o, m, l, lds + ALDS_V, lane);
    }
    l += __shfl_xor(l, 32);
    store_ot<128>(o, 1.0f / l, A.att + row * ATTW + 1024 + h * 128, hi);
}
DEV void attention_phase(const AttnArgs& A, LAS char* lds, int c, int G, int dup) {
    const int lane = threadIdx.x & 63;
    const float lam = __expf(wave_sum(A.lq1[lane] * A.lk1[lane])) - __expf(wave_sum(A.lq2[lane] * A.lk2[lane])) + 0.2f;
    for (int uu = c; uu < dup * NB * 4 * 16; uu += G) { const int u = uu & 511; diff_unit(A, lds, u >> 6, (u >> 4) & 3, u & 15, lam); }
    __syncthreads();
    for (int i = threadIdx.x; i < 8 * 15 * 31; i += NTHR) ((LAS float*)(lds + ALDS_X))[i] = A.rpb[i] * LOG2E;
    for (int uu = c; uu < dup * NB * 32 * 2; uu += G) { const int u = uu & 511; na_unit(A, lds, u >> 6, (u >> 1) & 31, u & 1); }
    for (int uu = c; uu < dup * NB * 4 * 8; uu += G) { const int u = uu & 255; mem_unit(A, lds, u >> 5, (u >> 3) & 3, u & 7); }
}


#define XB_TMO      128
#define XB_XCNT(j)  (256  + 64 * (j))
#define XB_XSUB(j)  (1280 + 64 * (j))
#define XB_XGEN(j)  (2304 + 64 * (j))
#define XB_TOP      3328
#define XB_TOPGEN   3392
#define XCD_BAR_WORDS 3456
#define XB_SPIN_CAP (1u << 18)

__device__ __forceinline__ unsigned xb_ld(unsigned* p)              { return __hip_atomic_load(p, __ATOMIC_RELAXED, __HIP_MEMORY_SCOPE_AGENT); }
__device__ __forceinline__ unsigned xb_add(unsigned* p, unsigned v) { return __hip_atomic_fetch_add(p, v, __ATOMIC_RELAXED, __HIP_MEMORY_SCOPE_AGENT); }
__device__ __forceinline__ unsigned xb_xcc_id() { return (unsigned)__builtin_amdgcn_s_getreg((3 << 11) | 20) & 0xFu; }
#define XB_SPIN(cond, bar) do { unsigned _sp = 0; while (cond) { __builtin_amdgcn_s_sleep(1); \
    if ((++_sp & 255u) == 0u) { if (xb_ld(&(bar)[XB_TMO])) break; if (_sp > XB_SPIN_CAP) { atomicAdd(&(bar)[XB_TMO], 1u); break; } } } } while (0)

struct XcdBarrier {
    unsigned* bar; unsigned x;
    volatile LAS unsigned* st;
};

__device__ __forceinline__ XcdBarrier xcd_barrier_post(unsigned* bar, volatile LAS unsigned* st) {
    XcdBarrier b; b.bar = bar; b.x = xb_xcc_id(); b.st = st;
    if (threadIdx.x == 0) (void)xb_add(&bar[XB_XCNT(b.x)], 1u);
    return b;
}
__device__ __forceinline__ void xcd_barrier_complete(unsigned* bar, unsigned x, unsigned& nloc, unsigned& nx) {
    const unsigned G = gridDim.x * gridDim.y * gridDim.z;
    unsigned sum, cnt, mine, sp = 0u;
    for (;;) {
        sum = 0u; cnt = 0u; mine = 0u;
#pragma unroll
        for (unsigned j = 0; j < 16; ++j) { const unsigned c = xb_ld(&bar[XB_XCNT(j)]); sum += c; cnt += (c > 0u) ? 1u : 0u; mine = (j == x) ? c : mine; }
        if (sum == G) break;
        __builtin_amdgcn_s_sleep(1);
        if ((++sp & 255u) == 0u) { if (xb_ld(&bar[XB_TMO])) break; if (sp > XB_SPIN_CAP) { atomicAdd(&bar[XB_TMO], 1u); break; } }
    }
    nloc = mine > 0u ? mine : 1u; nx = cnt > 0u ? cnt : 1u;
}

__device__ __forceinline__ void xcd_barrier(const XcdBarrier& b) {
    asm volatile("s_waitcnt vmcnt(0)" ::: "memory");
    __syncthreads();
    if (threadIdx.x == 0) {
        unsigned* bar = b.bar;
        __builtin_amdgcn_s_waitcnt(0);
        unsigned nloc = b.st[0], nx = b.st[1];
        if (nloc == 0u) { xcd_barrier_complete(bar, b.x, nloc, nx); b.st[0] = nloc; b.st[1] = nx; }
        const unsigned old = xb_add(&bar[XB_XSUB(b.x)], 1u);
        const unsigned gen = old / nloc;
        if (old + 1u == (gen + 1u) * nloc) {
            __builtin_amdgcn_fence(__ATOMIC_RELEASE, "agent");
            asm volatile("s_waitcnt vmcnt(0)" ::: "memory");
            const unsigned og = xb_add(&bar[XB_TOP], 1u);
            const unsigned tg = og / nx;
            if (og + 1u == (tg + 1u) * nx) xb_add(&bar[XB_TOPGEN], 1u);
            else XB_SPIN(xb_ld(&bar[XB_TOPGEN]) == tg, bar);
            __builtin_amdgcn_fence(__ATOMIC_ACQUIRE, "agent");
            xb_add(&bar[XB_XGEN(b.x)], 1u);
            asm volatile("s_waitcnt vmcnt(0)" ::: "memory");
        } else {
            XB_SPIN(xb_ld(&bar[XB_XGEN(b.x)]) == gen, bar);
            __builtin_amdgcn_fence(__ATOMIC_ACQUIRE, "agent");
            asm volatile("s_waitcnt vmcnt(0)" ::: "memory");
        }
    }
    __syncthreads();
}


struct Args { const float* in[27]; float* out; unsigned char* ws; int ph_lo, ph_hi, coop, pad; };

__global__ void __launch_bounds__(NTHR, 2) fwd_megakernel(Args a) {
    extern __shared__ __attribute__((aligned(16))) unsigned char lds_raw[];
    LAS unsigned char* lds = (LAS unsigned char*)lds_raw;
    cg::grid_group grid = cg::this_grid();
    const int tid = threadIdx.x, lane = tid & 63, wave = __builtin_amdgcn_readfirstlane(tid >> 6);
    const int G = gridDim.x, c = blockIdx.x;
    unsigned char* ws = a.ws;
    const float *x = a.in[0], *mem = a.in[1], *ffn1_norm = a.in[2], *ffn1_wg = a.in[3], *ffn1_wu = a.in[4], *ffn1_wd = a.in[5], *mix_norm = a.in[6], *w_in = a.in[7], *na_rpb = a.in[8],
                *lq1 = a.in[9], *lk1 = a.in[10], *lq2 = a.in[11], *lk2 = a.in[12], *subln = a.in[13], *mem_norm = a.in[14], *w_mem_kv = a.in[15], *w_gate = a.in[16], *b_gate = a.in[17],
                *w_br_na = a.in[18], *w_br_diff = a.in[19], *w_br_mem = a.in[20], *w_out = a.in[21], *ffn2_norm = a.in[22], *ffn2_wg = a.in[23], *ffn2_wu = a.in[24], *ffn2_wd = a.in[25], *final_norm = a.in[26];
    bf16_t *W1T = (bf16_t*)(ws + WS_W1T), *WD1T = (bf16_t*)(ws + WS_WD1T), *WMIX = (bf16_t*)(ws + WS_WMIX), *WBR = (bf16_t*)(ws + WS_WBR), *WOUT = (bf16_t*)(ws + WS_WOUT),
           *W2T = (bf16_t*)(ws + WS_W2T), *WD2T = (bf16_t*)(ws + WS_WD2T), *XB = (bf16_t*)(ws + WS_XB), *MKV = (bf16_t*)(ws + WS_MKV), *HID = (bf16_t*)(ws + WS_HID),
           *PROJ = (bf16_t*)(ws + WS_PROJ), *GATES = (bf16_t*)(ws + WS_GATES), *ATT = (bf16_t*)(ws + WS_ATT), *X2B = (bf16_t*)(ws + WS_X2B);
    float* SSQ = (float*)(ws + WS_SSQ); float* out = a.out;
    const int lo = a.ph_lo, hi = a.ph_hi;
    volatile LAS unsigned* bst = (volatile LAS unsigned*)(lds + LDS_MISC);
    if (tid < 16) bst[tid] = 0u;
    __syncthreads();
    XcdBarrier bar; bar.bar = (unsigned*)(ws + WS_CTL); bar.x = 0; bar.st = bst;
    if (a.coop) bar = xcd_barrier_post((unsigned*)(ws + WS_CTL), bst);
    if (a.coop == 2) grid.sync();
#define IN(k) (lo <= (k) && (k) < hi)
#define SEAM(k) do { if (IN(k) && IN((k) + 1)) { if (a.coop) xcd_barrier(bar); } } while (0)

    if (IN(0)) {
        LAS float* scr = (LAS float*)(lds + wave * 16384);
        const int gw = c * NWAVES + wave, ngw = G * NWAVES;
        transpose_matrix<1>(ffn1_wg, D, FF, W1T, 0, ffn1_norm, scr, gw, ngw, lane);
        transpose_matrix<2>(ffn1_wu, D, FF, W1T, 0, ffn1_norm, scr, gw, ngw, lane);
        transpose_matrix<0>(ffn1_wd, FF, D, WD1T, 0, nullptr, scr, gw, ngw, lane);
        transpose_matrix<0>(w_in, D, INW, WMIX, 0, mix_norm, scr, gw, ngw, lane);
        transpose_matrix<0>(w_gate, D, GW, WMIX, INW, mix_norm, scr, gw, ngw, lane);
        transpose_matrix<0>(w_mem_kv, D, 1024, WMIX, INW + GW, mem_norm, scr, gw, ngw, lane);
        transpose_matrix<0>(w_br_na, 512, D, WBR, 0, nullptr, scr, gw, ngw, lane);
        transpose_matrix<0>(w_br_diff, 512, D, WBR, D, nullptr, scr, gw, ngw, lane);
        transpose_matrix<0>(w_br_mem, 512, D, WBR, 2 * D, nullptr, scr, gw, ngw, lane);
        transpose_matrix<0>(w_out, D, D, WOUT, 0, nullptr, scr, gw, ngw, lane);
        transpose_matrix<1>(ffn2_wg, D, FF, W2T, 0, ffn2_norm, scr, gw, ngw, lane);
        transpose_matrix<2>(ffn2_wu, D, FF, W2T, 0, ffn2_norm, scr, gw, ngw, lane);
        transpose_matrix<0>(ffn2_wd, FF, D, WD2T, 0, nullptr, scr, gw, ngw, lane);
        for (int r0 = gw; r0 < DUPF(0) * (M + MEMR); r0 += ngw) { const int r = r0 >= M + MEMR ? r0 - (M + MEMR) : r0; row_to_bf16(r < M ? x + (size_t)r * D : mem + (size_t)(r - M) * D, XB + (size_t)r * D, SSQ + (size_t)r * 16, lane); }
    }
    SEAM(0);
    if (IN(1)) {
        pg8::SchedRect S; S.so.init(M, 2 * FF); S.A = (const char*)XB; S.B = (const char*)W1T; S.at = (size_t)256 * D * 2; S.bt = (size_t)256 * D * 2; S.G = G; S.c = c; S.dup = DUPF(1);
        pg8::EpiSwiglu E{HID, SSQ};
        pg8::gemm_phase(lds, D, D, D, S, E);
    }
    SEAM(1);
    if (IN(2)) {
        pg8::SchedRect S; S.so.init(M, D); S.A = (const char*)HID; S.B = (const char*)WD1T; S.at = (size_t)256 * FF * 2; S.bt = (size_t)256 * FF * 2; S.G = G; S.c = c; S.dup = DUPF(2);
        pg8::EpiResid E{x, out, XB, SSQ, 0.5f};
        pg8::gemm_phase(lds, FF, FF, FF, S, E);
    }
    SEAM(2);
    if (IN(3)) {
        pg8::SchedP3 S; S.so.init(M, INW); S.A = (const char*)XB; S.B = (const char*)WMIX; S.at = (size_t)256 * D * 2; S.bt = (size_t)256 * D * 2; S.G = G; S.c = c; S.dup = DUPF(3);
        pg8::EpiProj E{PROJ, MKV, SSQ};
        pg8::gemm_phase(lds, D, D, D, S, E);
    }
    SEAM(3);
    if (IN(4)) {
        const AttnArgs A{PROJ, MKV, ATT, na_rpb, lq1, lk1, lq2, lk2, subln};
        attention_phase(A, (LAS char*)lds, c, G, DUPF(4));
    }
    SEAM(4);
    if (IN(5)) {
        pg8::SchedRect S; S.so.init(M, GW); S.A = (const char*)XB; S.B = (const char*)(WMIX + (size_t)INW * D); S.at = (size_t)256 * D * 2; S.bt = (size_t)256 * D * 2; S.G = G; S.c = c; S.dup = DUPF(5);
        pg8::EpiGate E{GATES, SSQ, b_gate};
        pg8::gemm_phase(lds, D, D, D, S, E);
    }
    SEAM(5);
    if (IN(6)) {
        pg8::SchedBr S; S.so.init(M, D); S.A = (const char*)ATT; S.B = (const char*)WBR; S.at = (size_t)256 * ATTW * 2; S.bt = (size_t)256 * 512 * 2; S.G = G; S.c = c; S.dup = DUPF(6);
        pg8::EpiMerge E{XB, GATES};
        pg8::gemm_phase(lds, 512, ATTW, 512, S, E);
    }
    SEAM(6);
    if (IN(7)) {
        pg8::SchedRect S; S.so.init(M, D); S.A = (const char*)XB; S.B = (const char*)WOUT; S.at = (size_t)256 * D * 2; S.bt = (size_t)256 * D * 2; S.G = G; S.c = c; S.dup = 1;
        pg8::EpiResid E{out, out, X2B, SSQ, 1.0f};
        pg8::gemm_phase(lds, D, D, D, S, E);
    }
    SEAM(7);
    if (IN(8)) {
        pg8::SchedRect S; S.so.init(M, 2 * FF); S.A = (const char*)X2B; S.B = (const char*)W2T; S.at = (size_t)256 * D * 2; S.bt = (size_t)256 * D * 2; S.G = G; S.c = c; S.dup = DUPF(8);
        pg8::EpiSwiglu E{HID, SSQ};
        pg8::gemm_phase(lds, D, D, D, S, E);
    }
    SEAM(8);
    if (IN(9)) {
        pg8::SchedRect S; S.so.init(M, D); S.A = (const char*)HID; S.B = (const char*)WD2T; S.at = (size_t)256 * FF * 2; S.bt = (size_t)256 * FF * 2; S.G = G; S.c = c; S.dup = 1;
        pg8::EpiResid E{out, out, nullptr, SSQ, 0.5f};
        pg8::gemm_phase(lds, FF, FF, FF, S, E);
    }
    SEAM(9);
    if (a.coop) for (int i_ = 0; i_ < PROBE_SYNCS; ++i_) xcd_barrier(bar);
    if (IN(10)) {
        const int gw = c * NWAVES + wave, ngw = G * NWAVES;
        f32x4 gn[4];
#pragma unroll
        for (int j = 0; j < 4; ++j) gn[j] = ((const f32x4*)final_norm)[lane + 64 * j];
        for (int r = gw; r < M; r += ngw) {
            const float rs = row_rstd(SSQ, r); f32x4* p = (f32x4*)(out + (size_t)r * D) + lane;
#pragma unroll
            for (int j = 0; j < 4; ++j) p[64 * j] = p[64 * j] * rs * gn[j];
        }
    }
#undef IN
#undef SEAM
}

extern "C" void kernel_launch(void* const* d_in, const int* in_sizes, int n_in, void* d_out, int out_size, void* d_ws, size_t ws_size, hipStream_t stream) {
    static int grid = 0;
    if (grid == 0) {
        if (n_in != 27 || out_size != M * D || ws_size < WS_END) { fprintf(stderr, "kernel_launch: unexpected problem (n_in %d out %d ws %zu)\n", n_in, out_size, ws_size); grid = -1; return; }
        int dev = 0, cus = 0, per_cu = 0;
        hipGetDevice(&dev); hipDeviceGetAttribute(&cus, hipDeviceAttributeMultiprocessorCount, dev);
        hipFuncSetAttribute((const void*)fwd_megakernel, hipFuncAttributeMaxDynamicSharedMemorySize, LDS_BYTES);
        if (hipOccupancyMaxActiveBlocksPerMultiprocessor(&per_cu, (const void*)fwd_megakernel, NTHR, LDS_BYTES) != hipSuccess || per_cu < 1) { fprintf(stderr, "kernel_launch: occupancy query says %d\n", per_cu); per_cu = 1; }
        (void)hipGetLastError();
        grid = cus * (per_cu > 1 ? 1 : per_cu);
    }
    if (grid < 0) return;
    Args a{};
    for (int i = 0; i < 27; ++i) a.in[i] = (const float*)d_in[i];
    a.out = (float*)d_out; a.ws = (unsigned char*)d_ws;
    if (MK_N_LAUNCHES == 1) {
        if (hipMemsetAsync((char*)d_ws + WS_CTL, 0, CTL_BYTES, stream) != hipSuccess) { fprintf(stderr, "kernel_launch: memset of the barrier words failed\n"); return; }
        a.ph_lo = 0; a.ph_hi = 11; a.coop = 1;
        void* args[] = {&a};
        hipError_t e = hipLaunchCooperativeKernel((const void*)fwd_megakernel, dim3(grid), dim3(NTHR), args, LDS_BYTES, stream);
        if (e != hipSuccess) fprintf(stderr, "cooperative launch failed: %s (grid %d)\n", hipGetErrorString(e), grid);
    } else {
        for (int p = 0; p < 11; ++p) { a.ph_lo = p; a.ph_hi = p + 1; a.coop = 0; hipLaunchKernelGGL(fwd_megakernel, dim3(grid), dim3(NTHR), LDS_BYTES, stream, a); }
    }
}
```

```cpp
#include <hip/hip_runtime.h>
#include <hip/hip_cooperative_groups.h>
#include <cstdio>
#include <cstdint>
namespace cg = cooperative_groups;

#ifndef MK_N_LAUNCHES
#define MK_N_LAUNCHES 1
#endif

#ifndef PROBE_DUP
#define PROBE_DUP 0
#endif
#ifndef PROBE_SYNCS
#define PROBE_SYNCS 0
#endif
#define DUPF(k) (1 + ((PROBE_DUP >> (k)) & 1))

#define LAS __attribute__((address_space(3)))
#define DEV __device__ __forceinline__
typedef unsigned short bf16_t;
typedef short bf16x8 __attribute__((ext_vector_type(8)));
typedef short s16x4 __attribute__((ext_vector_type(4)));
typedef float f32x2 __attribute__((ext_vector_type(2)));
typedef float f32x4 __attribute__((ext_vector_type(4)));
typedef float f32x16 __attribute__((ext_vector_type(16)));
typedef unsigned u32x2 __attribute__((ext_vector_type(2)));
typedef unsigned u32x4 __attribute__((ext_vector_type(4)));
typedef __bf16 bf16x2_t __attribute__((ext_vector_type(2)));

constexpr int M = 16384, D = 1024, FF = 2816, INW = 3584, GW = 3072, SEQ = 2048, NB = 8, MEMT = 256, MEMR = NB * MEMT;
constexpr int O_NQ = 0, O_NK = 512, O_NV = 1024, O_DQ = 1536, O_DK = 2048, O_DV = 2560, O_MQ = 3072;
constexpr int ATTW = 1536;
constexpr float EPS = 1e-6f, LOG2E = 1.4426950408889634f;
constexpr int NTHR = 512, NWAVES = 8;
constexpr int LDS_BYTES = 147456, LDS_MISC = LDS_BYTES - 64;

constexpr size_t MiB = 1u << 20;
constexpr size_t WS_W1T = 0, WS_WD1T = 11 * MiB, WS_WMIX = WS_WD1T + 11 * MiB / 2, WS_WBR = WS_WMIX + 15 * MiB, WS_WOUT = WS_WBR + 3 * MiB,
                 WS_W2T = WS_WOUT + 2 * MiB, WS_WD2T = WS_W2T + 11 * MiB, WS_XB = 53 * MiB, WS_SSQ = 89 * MiB, WS_MKV = 91 * MiB, WS_OV = 96 * MiB;
constexpr size_t WS_CTL = 95 * MiB, CTL_BYTES = 16384;
constexpr size_t WS_HID = WS_OV, WS_PROJ = WS_OV, WS_GATES = WS_OV, WS_ATT = 208 * MiB, WS_X2B = 208 * MiB, WS_END = 256 * MiB;
static_assert(WS_WD2T + 11 * MiB / 2 == WS_XB, "weights end at 53 MiB");
static_assert(WS_PROJ + (size_t)M * INW * 2 == WS_ATT && WS_ATT + (size_t)M * ATTW * 2 == WS_END, "overlay map");

DEV unsigned cvtpk(float lo, float hi) { f32x2 v = {lo, hi}; bf16x2_t b = __builtin_convertvector(v, bf16x2_t); return __builtin_bit_cast(unsigned, b); }
DEV float bf_lo(unsigned w) { return __uint_as_float(w << 16); }
DEV float bf_hi(unsigned w) { return __uint_as_float(w & 0xffff0000u); }
DEV float wave_sum(float v) {
#pragma unroll
    for (int o = 1; o < 64; o <<= 1) v += __shfl_xor(v, o);
    return v;
}
DEV float row_rstd(const float* ssq, int row) {
    const f32x4* p = (const f32x4*)(ssq + (size_t)row * 16);
    const f32x4 a = p[0], b = p[1], c = p[2], d = p[3];
    const float s = ((a[0] + a[1]) + (a[2] + a[3])) + ((b[0] + b[1]) + (b[2] + b[3])) + ((c[0] + c[1]) + (c[2] + c[3])) + ((d[0] + d[1]) + (d[2] + d[3]));
    return __builtin_amdgcn_rsqf(s * (1.0f / D) + EPS);
}

namespace pg8 {
constexpr int BM = 256, BK = 64, HALF = 128, HTB = HALF * BK * 2, STAGE_BYTES = 8 * HTB, NXCD = 8, WGM = 8;
__host__ __device__ __forceinline__ int lds_byte(int r, int c) { const int st = (r >> 4) * 2 + (c >> 5), rr = r & 15, cc = c & 31, ob = rr * 64 + cc * 2; return st * 1024 + (ob ^ (((ob >> 9) & 1) << 5)); }
__host__ __device__ __forceinline__ void stage_rc(int b, int& R, int& C) { const int st = b / 1024, sb = b % 1024, swz = sb ^ (((sb >> 9) & 1) << 5); R = (st >> 1) * 16 + swz / 64; C = (st & 1) * 32 + (swz % 64) / 2; }
__host__ __device__ __forceinline__ int perm32(int rho) { const int n = rho >> 4, i = rho & 15; return 8 * (i >> 2) + 4 * n + (i & 3); }

struct Unit { int pm, pn, br; };

struct StaticOrder {
    int nM, nN, nwg;
    __device__ void init(int M_, int N_) { nM = M_ / BM; nN = N_ / BM; nwg = nM * nN; }
    __device__ void map(int L, Unit& u) const {
        int wgid = L; { const int q = nwg / NXCD, r = nwg % NXCD, xcd = wgid % NXCD, off = wgid / NXCD; wgid = (xcd < r ? xcd * (q + 1) : r * (q + 1) + (xcd - r) * q) + off; }
        const int nig = WGM * nN, gid = wgid / nig, fm = gid * WGM, gsz = (nM - fm) < WGM ? (nM - fm) : WGM;
        u.pm = fm + ((wgid % nig) % gsz); u.pn = (wgid % nig) / gsz; u.br = 0;
    }
};
struct SchedRect {
    StaticOrder so; const char* A; const char* B; size_t at, bt; int G, c, dup;
    DEV bool next(int i, Unit& u) const { int L = i * G + c; if (L >= dup * so.nwg) return false; if (L >= so.nwg) L -= so.nwg; so.map(L, u); return true; }
    DEV const char* aptr(const Unit& u) const { return A + (size_t)u.pm * at; }
    DEV const char* bptr(const Unit& u) const { return B + (size_t)u.pn * bt; }
};
struct SchedP3 {
    StaticOrder so; const char* A; const char* B; size_t at, bt; int G, c, dup;
    DEV bool next(int i, Unit& u) const {
        int L = i * G + c; if (dup > 1 && L >= so.nwg + 32) L -= so.nwg + 32;
        if (L < so.nwg) { so.map(L, u); return true; }
        const int e = L - so.nwg; if (e >= 32) return false;
        u.pm = 64 + (e >> 2); u.pn = 26 + (e & 3); u.br = 0; return true;
    }
    DEV const char* aptr(const Unit& u) const { return A + (size_t)u.pm * at; }
    DEV const char* bptr(const Unit& u) const { return B + (size_t)u.pn * bt; }
};
struct SchedBr {
    StaticOrder so; const char* A; const char* B; size_t at, bt; int G, c, dup;
    DEV bool next(int i, Unit& u) const { int L = (i / 3) * G + c; if (L >= dup * so.nwg) return false; if (L >= so.nwg) L -= so.nwg; so.map(L, u); u.br = i % 3; return true; }
    DEV const char* aptr(const Unit& u) const { return A + (size_t)u.pm * at + (size_t)u.br * 512 * 2; }
    DEV const char* bptr(const Unit& u) const { return B + ((size_t)u.br * 4 + u.pn) * bt; }
};

typedef f32x4 Acc[2][2][4][2];

DEV float silu_mul(float g, float u) { return g * u * __builtin_amdgcn_rcpf(1.0f + __builtin_amdgcn_exp2f(-LOG2E * g)); }
DEV float sigm(float v) { return __builtin_amdgcn_rcpf(1.0f + __builtin_amdgcn_exp2f(-LOG2E * v)); }

struct EpiSwiglu {
    static constexpr bool PERM = true;
    bf16_t* H; const float* ssq;
    DEV void operator()(const Acc& acc, const Unit& u, int wr, int wc, int fr, int fq) const {
        const int row0 = u.pm * BM + wr * 64 + fr, col0 = u.pn * 128 + wc * 32 + 8 * fq;
#pragma unroll
        for (int ai = 0; ai < 2; ++ai)
#pragma unroll
            for (int m = 0; m < 4; ++m) {
                const int row = row0 + ai * HALF + m * 16; const float rs = row_rstd(ssq, row);
                const f32x4 g0 = acc[ai][0][m][0] * rs, g1 = acc[ai][0][m][1] * rs, u0 = acc[ai][1][m][0] * rs, u1 = acc[ai][1][m][1] * rs;
                u32x4 w;
                w.x = cvtpk(silu_mul(g0[0], u0[0]), silu_mul(g0[1], u0[1])); w.y = cvtpk(silu_mul(g0[2], u0[2]), silu_mul(g0[3], u0[3]));
                w.z = cvtpk(silu_mul(g1[0], u1[0]), silu_mul(g1[1], u1[1])); w.w = cvtpk(silu_mul(g1[2], u1[2]), silu_mul(g1[3], u1[3]));
                *(u32x4*)(H + (size_t)row * FF + col0) = w;
            }
    }
};
struct EpiResid {
    static constexpr bool PERM = false;
    const float* base; float* out; bf16_t* xb; float* ssq; float s;
    DEV void operator()(const Acc& acc, const Unit& u, int wr, int wc, int fr, int fq) const {
        const int row0 = u.pm * BM + wr * 64 + fr, col0 = u.pn * BM + wc * 32 + 4 * fq;
#pragma unroll
        for (int ai = 0; ai < 2; ++ai)
#pragma unroll
            for (int m = 0; m < 4; ++m) {
                const int row = row0 + ai * HALF + m * 16; const size_t off = (size_t)row * D + col0; float q = 0.f;
#pragma unroll
                for (int bj = 0; bj < 2; ++bj)
#pragma unroll
                    for (int n = 0; n < 2; ++n) {
                        const f32x4 b = *(const f32x4*)(base + off + bj * HALF + n * 16);
                        const f32x4 v = b + acc[ai][bj][m][n] * s;
                        *(f32x4*)(out + off + bj * HALF + n * 16) = v;
                        if (xb) { u32x2 w; w.x = cvtpk(v[0], v[1]); w.y = cvtpk(v[2], v[3]); *(u32x2*)(xb + off + bj * HALF + n * 16) = w; }
                        q += (v[0] * v[0] + v[1] * v[1]) + (v[2] * v[2] + v[3] * v[3]);
                    }
                q += __shfl_xor(q, 16); q += __shfl_xor(q, 32);
                if (fq == 0) ssq[(size_t)row * 16 + u.pn * 4 + wc] = q;
                asm volatile("" ::: "memory");
            }
    }
};
struct EpiProj {
    static constexpr bool PERM = true;
    bf16_t* P; bf16_t* MKV; const float* ssq;
    DEV void operator()(const Acc& acc, const Unit& u, int wr, int wc, int fr, int fq) const {
        const int row0 = u.pm * BM + wr * 64 + fr; const bool mem = u.pm >= 64;
        bf16_t* base = mem ? MKV + (size_t)(row0 - M) * 1024 + (u.pn - 26) * BM : P + (size_t)row0 * INW + u.pn * BM;
        const size_t ldc = mem ? 1024 : INW; base += wc * 32 + 8 * fq;
#pragma unroll
        for (int ai = 0; ai < 2; ++ai)
#pragma unroll
            for (int m = 0; m < 4; ++m) {
                const int row = row0 + ai * HALF + m * 16; const float rs = row_rstd(ssq, row);
                bf16_t* rp = base + (size_t)(ai * HALF + m * 16) * ldc;
#pragma unroll
                for (int bj = 0; bj < 2; ++bj) {
                    const f32x4 v0 = acc[ai][bj][m][0] * rs, v1 = acc[ai][bj][m][1] * rs; u32x4 w;
                    w.x = cvtpk(v0[0], v0[1]); w.y = cvtpk(v0[2], v0[3]); w.z = cvtpk(v1[0], v1[1]); w.w = cvtpk(v1[2], v1[3]);
                    *(u32x4*)(rp + bj * HALF) = w;
                }
            }
    }
};
struct EpiGate {
    static constexpr bool PERM = true;
    bf16_t* Gt; const float* ssq; const float* bias;
    DEV void operator()(const Acc& acc, const Unit& u, int wr, int wc, int fr, int fq) const {
        const int row0 = u.pm * BM + wr * 64 + fr, col0 = u.pn * BM + wc * 32 + 8 * fq;
        f32x4 bv[2][2];
#pragma unroll
        for (int bj = 0; bj < 2; ++bj)
#pragma unroll
            for (int n = 0; n < 2; ++n) bv[bj][n] = *(const f32x4*)(bias + col0 + bj * HALF + 4 * n);
#pragma unroll
        for (int ai = 0; ai < 2; ++ai)
#pragma unroll
            for (int m = 0; m < 4; ++m) {
                const int row = row0 + ai * HALF + m * 16; const float rs = row_rstd(ssq, row);
#pragma unroll
                for (int bj = 0; bj < 2; ++bj) {
                    const f32x4 v0 = acc[ai][bj][m][0] * rs + bv[bj][0], v1 = acc[ai][bj][m][1] * rs + bv[bj][1]; u32x4 w;
                    w.x = cvtpk(sigm(v0[0]), sigm(v0[1])); w.y = cvtpk(sigm(v0[2]), sigm(v0[3])); w.z = cvtpk(sigm(v1[0]), sigm(v1[1])); w.w = cvtpk(sigm(v1[2]), sigm(v1[3]));
                    *(u32x4*)(Gt + (size_t)row * GW + col0 + bj * HALF) = w;
                }
            }
    }
};
struct EpiMerge {
    static constexpr bool PERM = true;
    bf16_t* Mg; const bf16_t* Gt;
    DEV void operator()(const Acc& acc, const Unit& u, int wr, int wc, int fr, int fq) const {
        const int row0 = u.pm * BM + wr * 64 + fr, col0 = u.pn * BM + wc * 32 + 8 * fq;
#pragma unroll
        for (int ai = 0; ai < 2; ++ai)
#pragma unroll
            for (int m = 0; m < 4; ++m) {
                const int row = row0 + ai * HALF + m * 16;
#pragma unroll
                for (int bj = 0; bj < 2; ++bj) {
                    const u32x4 g = *(const u32x4*)(Gt + (size_t)row * GW + u.br * D + col0 + bj * HALF);
                    bf16_t* mp = Mg + (size_t)row * D + col0 + bj * HALF;
                    const f32x4 a0 = acc[ai][bj][m][0], a1 = acc[ai][bj][m][1];
                    float v[8] = {bf_lo(g.x) * a0[0], bf_hi(g.x) * a0[1], bf_lo(g.y) * a0[2], bf_hi(g.y) * a0[3], bf_lo(g.z) * a1[0], bf_hi(g.z) * a1[1], bf_lo(g.w) * a1[2], bf_hi(g.w) * a1[3]};
                    if (u.br != 0) { const u32x4 o = *(const u32x4*)mp;
                        v[0] += bf_lo(o.x); v[1] += bf_hi(o.x); v[2] += bf_lo(o.y); v[3] += bf_hi(o.y); v[4] += bf_lo(o.z); v[5] += bf_hi(o.z); v[6] += bf_lo(o.w); v[7] += bf_hi(o.w); }
                    u32x4 w; w.x = cvtpk(v[0], v[1]); w.y = cvtpk(v[2], v[3]); w.z = cvtpk(v[4], v[5]); w.w = cvtpk(v[6], v[7]);
                    *(u32x4*)mp = w;
                }
            }
        asm volatile("s_waitcnt vmcnt(0)" ::: "memory");
    }
};

template <class Epi, class Sched>
DEV void gemm_phase(LAS unsigned char* lds, const int K, const int lda, const int ldb, const Sched& S, const Epi& E) {
    const int tid = threadIdx.x, wid = __builtin_amdgcn_readfirstlane(tid >> 6), lane = tid & 63, wr = wid >> 2, wc = wid & 3, fr = lane & 15, fq = lane >> 4;
    const int nt = K / BK;
    unsigned voffA[2], voffB[2];
#pragma unroll
    for (int i = 0; i < 2; ++i) { int R, C; stage_rc(tid * 16 + i * 8192, R, C); const int Rb = Epi::PERM ? ((R & ~31) + perm32(R & 31)) : R;
        voffA[i] = (unsigned)(R * lda + C) * 2u; voffB[i] = (unsigned)(Rb * ldb + C) * 2u; }
    const size_t kstep = (size_t)(BK * 2);
    const size_t hstepA = (size_t)HALF * lda * 2, hstepB = (size_t)HALF * ldb * 2;
    const unsigned ldsw = (unsigned)wid * 1024u;
    const int aoff = lds_byte(wr * 64 + fr, fq * 8), boff = lds_byte(wc * 32 + fr, fq * 8);
#define PG8_SA(b, h) (((b) * 2 + (h)) * HTB)
#define PG8_SB(b, h) ((4 + (b) * 2 + (h)) * HTB)
#define PG8_STAGE(bufoff, gbase, voff) do { _Pragma("unroll") for (int _i = 0; _i < 2; ++_i) \
        __builtin_amdgcn_global_load_lds((const unsigned*)((const char*)(gbase) + (voff)[_i]), (LAS unsigned*)(lds + (bufoff) + ldsw + _i * 8192), 16, 0, 0); } while (0)
#define PG8_LDA(dst, b, h) do { _Pragma("unroll") for (int m = 0; m < 4; ++m) _Pragma("unroll") for (int k = 0; k < 2; ++k) dst[m][k] = *(const LAS bf16x8*)(lds + PG8_SA(b, h) + aoff + m * 2048 + k * 1024); } while (0)
#define PG8_LDB(dst, b, h) do { _Pragma("unroll") for (int n = 0; n < 2; ++n) _Pragma("unroll") for (int k = 0; k < 2; ++k) dst[n][k] = *(const LAS bf16x8*)(lds + PG8_SB(b, h) + boff + n * 2048 + k * 1024); } while (0)
#define PG8_MMA(ai, bj, At, Bt) do { __builtin_amdgcn_s_setprio(1); _Pragma("unroll") for (int m = 0; m < 4; ++m) _Pragma("unroll") for (int n = 0; n < 2; ++n) _Pragma("unroll") for (int k = 0; k < 2; ++k) \
        acc[ai][bj][m][n] = __builtin_amdgcn_mfma_f32_16x16x32_bf16(Bt[n][k], At[m][k], acc[ai][bj][m][n], 0, 0, 0); __builtin_amdgcn_s_setprio(0); } while (0)
#define PG8_WAIT_V(n) asm volatile("s_waitcnt vmcnt(" #n ")" ::: "memory")
#define PG8_WAIT_L(n) asm volatile("s_waitcnt lgkmcnt(" #n ")" ::: "memory")
#define PG8_BAR __builtin_amdgcn_s_barrier()
#define PG8_SCHED __builtin_amdgcn_sched_barrier(0)
    Unit cur, nxt; int ui = 0;
    if (!S.next(0, cur)) return;
    Acc acc;
#pragma unroll
    for (int a = 0; a < 2; ++a)
#pragma unroll
        for (int b = 0; b < 2; ++b)
#pragma unroll
            for (int m = 0; m < 4; ++m)
#pragma unroll
                for (int n = 0; n < 2; ++n) acc[a][b][m][n] = (f32x4){0.f, 0.f, 0.f, 0.f};
    bf16x8 At[4][2], B0[2][2], B1[2][2];
    const char* cA = S.aptr(cur); const char* cB = S.bptr(cur);
    PG8_STAGE(PG8_SB(0, 0), cB, voffB); PG8_STAGE(PG8_SB(0, 1), cB + hstepB, voffB); PG8_STAGE(PG8_SA(0, 0), cA, voffA); PG8_STAGE(PG8_SA(0, 1), cA + hstepA, voffA);
    if (wr == 1) PG8_BAR;
    PG8_WAIT_V(2); PG8_BAR;
    PG8_STAGE(PG8_SB(1, 0), cB + kstep, voffB); PG8_STAGE(PG8_SA(1, 0), cA + kstep, voffA); PG8_STAGE(PG8_SB(1, 1), cB + hstepB + kstep, voffB);
    PG8_WAIT_V(6); PG8_BAR;
    for (;;) {
        const bool has_next = S.next(ui + 1, nxt);
        const char* nA = has_next ? S.aptr(nxt) : cA; const char* nB = has_next ? S.bptr(nxt) : cB;
        for (int t = 0; t < nt; t += 2) {
            const bool last = (t == nt - 2);
            const char* a1 = cA + (size_t)(t + 1) * kstep;
            const char* a2 = last ? nA : cA + (size_t)(t + 2) * kstep; const char* b2 = last ? nB : cB + (size_t)(t + 2) * kstep;
            const char* a3 = a2 + kstep; const char* b3 = b2 + kstep;
            PG8_LDB(B0, 0, 0); PG8_LDB(B1, 0, 1); PG8_SCHED; PG8_LDA(At, 0, 0); PG8_STAGE(PG8_SA(1, 1), a1 + hstepA, voffA);
            PG8_WAIT_V(8); PG8_WAIT_L(0); PG8_BAR; PG8_MMA(0, 0, At, B0); PG8_MMA(0, 1, At, B1); PG8_BAR; PG8_SCHED;
            PG8_LDA(At, 0, 1); PG8_STAGE(PG8_SB(0, 0), b2, voffB); PG8_STAGE(PG8_SB(0, 1), b2 + hstepB, voffB); PG8_STAGE(PG8_SA(0, 0), a2, voffA);
            PG8_WAIT_V(8); PG8_WAIT_L(0); PG8_BAR; PG8_MMA(1, 0, At, B0); PG8_MMA(1, 1, At, B1); PG8_BAR; PG8_SCHED;
            PG8_LDB(B0, 1, 0); PG8_LDB(B1, 1, 1); PG8_SCHED; PG8_LDA(At, 1, 0); PG8_STAGE(PG8_SA(0, 1), a2 + hstepA, voffA);
            PG8_WAIT_V(8); PG8_WAIT_L(0); PG8_BAR; PG8_MMA(0, 0, At, B0); PG8_MMA(0, 1, At, B1); PG8_BAR; PG8_SCHED;
            PG8_LDA(At, 1, 1); PG8_STAGE(PG8_SB(1, 0), b3, voffB); PG8_STAGE(PG8_SB(1, 1), b3 + hstepB, voffB); PG8_STAGE(PG8_SA(1, 0), a3, voffA);
            PG8_WAIT_V(8); PG8_WAIT_L(0); PG8_BAR; PG8_MMA(1, 0, At, B0); PG8_MMA(1, 1, At, B1); PG8_BAR; PG8_SCHED;
        }
        if (wr == 0) PG8_BAR;
        E(acc, cur, wr, wc, fr, fq);
        if (!has_next) break;
#pragma unroll
        for (int a = 0; a < 2; ++a)
#pragma unroll
            for (int b = 0; b < 2; ++b)
#pragma unroll
                for (int m = 0; m < 4; ++m)
#pragma unroll
                    for (int n = 0; n < 2; ++n) acc[a][b][m][n] = (f32x4){0.f, 0.f, 0.f, 0.f};
        cur = nxt; cA = nA; cB = nB; ++ui;
        if (wr == 1) PG8_BAR;
    }
    PG8_WAIT_V(0);
    PG8_BAR;
#undef PG8_SA
#undef PG8_SB
#undef PG8_STAGE
#undef PG8_LDA
#undef PG8_LDB
#undef PG8_MMA
#undef PG8_WAIT_V
#undef PG8_WAIT_L
#undef PG8_BAR
#undef PG8_SCHED
}
}

DEV void transpose_item(const float* W, int K, int N, bf16_t* WT, int k0, int n0, int dst_row0, const float* gain, float cscale, LAS float* scr, int lane) {
    float wv[32];
#pragma unroll
    for (int i = 0; i < 32; ++i) wv[i] = __builtin_nontemporal_load(W + (size_t)(k0 + 2 * i + (lane >> 5)) * N + n0 + (lane & 31));
    const int c = lane & 7;
    f32x4 g0 = {cscale, cscale, cscale, cscale}, g1 = g0;
    if (gain) { g0 = *(const f32x4*)(gain + k0 + 8 * c) * cscale; g1 = *(const f32x4*)(gain + k0 + 8 * c + 4) * cscale; }
#pragma unroll
    for (int i = 0; i < 32; ++i) scr[(2 * i + (lane >> 5)) * 33 + (lane & 31)] = wv[i];
    asm volatile("s_waitcnt lgkmcnt(0)" ::: "memory");
#pragma unroll
    for (int j = 0; j < 4; ++j) { const int n = (lane >> 3) + 8 * j; const LAS float* s = scr + (8 * c) * 33 + n;
        u32x4 o; o.x = cvtpk(s[0 * 33] * g0[0], s[1 * 33] * g0[1]); o.y = cvtpk(s[2 * 33] * g0[2], s[3 * 33] * g0[3]); o.z = cvtpk(s[4 * 33] * g1[0], s[5 * 33] * g1[1]); o.w = cvtpk(s[6 * 33] * g1[2], s[7 * 33] * g1[3]);
        *(u32x4*)(WT + (size_t)(dst_row0 + n) * K + k0 + 8 * c) = o; }
    asm volatile("s_waitcnt lgkmcnt(0)" ::: "memory");
}
template <int MODE>
DEV void transpose_matrix(const float* W, int K, int N, bf16_t* WT, int row_off, const float* gain, LAS float* scr, int gw, int ngw, int lane) {
    const int nblk = N / 32, nitems = (K / 64) * nblk;
    for (int it0 = gw; it0 < DUPF(0) * nitems; it0 += ngw) {
        const int it = it0 >= nitems ? it0 - nitems : it0;
        const int kb = it / nblk, nb = it % nblk, n0 = 32 * nb;
        const int dr = MODE == 0 ? row_off + n0 : 256 * (n0 >> 7) + 128 * (MODE - 1) + (n0 & 127);
        transpose_item(W, K, N, WT, 64 * kb, n0, dr, gain, 1.0f, scr, lane);
    }
}
DEV void rowv_to_bf16(const f32x4 (&v)[4], bf16_t* orow, float* ssq_row, int lane) {
    float s = 0.f;
#pragma unroll
    for (int j = 0; j < 4; ++j) s += (v[j][0] * v[j][0] + v[j][1] * v[j][1]) + (v[j][2] * v[j][2] + v[j][3] * v[j][3]);
    s = wave_sum(s);
    u32x2* o8 = (u32x2*)orow + lane;
#pragma unroll
    for (int j = 0; j < 4; ++j) { u32x2 w; w.x = cvtpk(v[j][0], v[j][1]); w.y = cvtpk(v[j][2], v[j][3]); o8[64 * j] = w; }
    if (lane < 16) ssq_row[lane] = lane == 0 ? s : 0.f;
}

#define MFMA32(a, b, c) __builtin_amdgcn_mfma_f32_32x32x16_bf16((a), (b), (c), 0, 0, 0)
typedef short v4i16_t __attribute__((ext_vector_type(4)));
DEV s16x4 vtr(const LAS char* p) { return __builtin_bit_cast(s16x4, __builtin_amdgcn_ds_read_tr16_b64_v4i16((LAS v4i16_t*)p)); }
DEV int crow(int r, int hi) { return (r & 3) + 8 * (r >> 2) + 4 * hi; }
constexpr float NEG_BIG = -3.0e38f;

constexpr int ALDS_V = 0, ALDS_K = 36864, ALDS_X = 70656;
static_assert(ALDS_X + 65536 <= 131072 + 8192, "attention LDS");

template <int NCH> DEV void tile_gload(u32x4 (&st)[NCH / 8], const char* g, size_t gp, int tid) {
#pragma unroll
    for (int i = 0; i < NCH / 8; ++i) { const int c = tid + NTHR * i, row = c / NCH, ch = c % NCH; st[i] = *(const u32x4*)(g + (size_t)row * gp + ch * 16); }
}
template <int NCH, int PITCH> DEV void tile_swrite(const u32x4 (&st)[NCH / 8], LAS char* l, int tid) {
#pragma unroll
    for (int i = 0; i < NCH / 8; ++i) { const int c = tid + NTHR * i, row = c / NCH, ch = c % NCH; *(LAS u32x4*)(l + row * PITCH + ch * 16) = st[i]; }
}
template <int DK, int KP> DEV void qk_tile(f32x16& p0, f32x16& p1, const LAS char* Kt, const bf16x8 (&qf)[DK / 16], int r32, int hi) {
    const LAS char* ka = Kt + r32 * KP + hi * 16;
#pragma unroll
    for (int r = 0; r < 16; ++r) { p0[r] = 0.f; p1[r] = 0.f; }
#pragma unroll
    for (int ks = 0; ks < DK / 16; ++ks) {
        const bf16x8 a0 = *(const LAS bf16x8*)(ka + ks * 32), a1 = *(const LAS bf16x8*)(ka + 32 * KP + ks * 32);
        p0 = MFMA32(a0, qf[ks], p0); p1 = MFMA32(a1, qf[ks], p1);
    }
}
template <int DV, int VP> DEV void softmax_pv(f32x16& p0, f32x16& p1, f32x16 (&o)[DV / 32], float& m, float& l, const LAS char* Vt, int lane) {
    float mx = fmaxf(p0[0], p1[0]);
#pragma unroll
    for (int r = 1; r < 16; ++r) mx = fmaxf(mx, fmaxf(p0[r], p1[r]));
    mx = fmaxf(mx, __shfl_xor(mx, 32));
    const float mnew = fmaxf(m, mx), alpha = __builtin_amdgcn_exp2f(m - mnew);
    m = mnew; float s = 0.f;
#pragma unroll
    for (int r = 0; r < 16; ++r) { p0[r] = __builtin_amdgcn_exp2f(p0[r] - mnew); p1[r] = __builtin_amdgcn_exp2f(p1[r] - mnew); s += p0[r] + p1[r]; }
    l = l * alpha + s;
    if (__any(alpha != 1.0f)) {
#pragma unroll
        for (int d = 0; d < DV / 32; ++d)
#pragma unroll
            for (int r = 0; r < 16; ++r) o[d][r] *= alpha;
    }
    const int hi = lane >> 5;
    const LAS char* va = Vt + (4 * hi + ((lane & 15) >> 2)) * VP + (16 * ((lane >> 4) & 1) + 4 * (lane & 3)) * 2;
#pragma unroll
    for (int s4 = 0; s4 < 4; ++s4) {
        u32x4 pw;
        if (s4 == 0) { pw.x = cvtpk(p0[0], p0[1]); pw.y = cvtpk(p0[2], p0[3]); pw.z = cvtpk(p0[4], p0[5]); pw.w = cvtpk(p0[6], p0[7]); }
        else if (s4 == 1) { pw.x = cvtpk(p0[8], p0[9]); pw.y = cvtpk(p0[10], p0[11]); pw.z = cvtpk(p0[12], p0[13]); pw.w = cvtpk(p0[14], p0[15]); }
        else if (s4 == 2) { pw.x = cvtpk(p1[0], p1[1]); pw.y = cvtpk(p1[2], p1[3]); pw.z = cvtpk(p1[4], p1[5]); pw.w = cvtpk(p1[6], p1[7]); }
        else { pw.x = cvtpk(p1[8], p1[9]); pw.y = cvtpk(p1[10], p1[11]); pw.z = cvtpk(p1[12], p1[13]); pw.w = cvtpk(p1[14], p1[15]); }
        const bf16x8 pf = __builtin_bit_cast(bf16x8, pw);
#pragma unroll
        for (int d = 0; d < DV / 32; ++d) {
            const s16x4 lo = vtr(va + (16 * s4) * VP + d * 64), hh = vtr(va + (16 * s4 + 8) * VP + d * 64);
            const bf16x8 vf = __builtin_shufflevector(lo, hh, 0, 1, 2, 3, 4, 5, 6, 7);
            o[d] = MFMA32(vf, pf, o[d]);
        }
    }
}
template <int DV> DEV void store_ot(const f32x16 (&o)[DV / 32], float inv, bf16_t* orow, int hi) {
#pragma unroll
    for (int d = 0; d < DV / 32; ++d)
#pragma unroll
        for (int g = 0; g < 4; ++g) { u32x2 w; w.x = cvtpk(o[d][4 * g] * inv, o[d][4 * g + 1] * inv); w.y = cvtpk(o[d][4 * g + 2] * inv, o[d][4 * g + 3] * inv);
            *(u32x2*)(orow + 32 * d + 8 * g + 4 * hi) = w; }
}

struct AttnArgs { const bf16_t* proj; const bf16_t* mkv; bf16_t* att; const float* rpb; const float* lq1; const float* lk1; const float* lq2; const float* lk2; const float* subln; };

DEV void diff_unit(const AttnArgs& A, LAS char* lds, int b, int h, int qb, float lam) {
    constexpr int KP = 272, VP = 320, NT = SEQ / 64;
    const int tid = threadIdx.x, lane = tid & 63, r32 = lane & 31, hi = lane >> 5, wid = __builtin_amdgcn_readfirstlane(tid >> 6), map = wid >> 2;
    const size_t rowb = (size_t)b * SEQ; const int q0 = qb * 128 + (wid & 3) * 32;
    const bf16_t* qp = A.proj + (rowb + q0 + r32) * INW + O_DQ + h * 128 + map * 64 + hi * 8;
    bf16x8 qf[4];
#pragma unroll
    for (int ks = 0; ks < 4; ++ks) qf[ks] = *(const bf16x8*)(qp + ks * 16);
    const char* kg = (const char*)(A.proj + rowb * INW + O_DK + h * 128); const char* vg = (const char*)(A.proj + rowb * INW + O_DV + h * 128);
    const size_t gp = (size_t)INW * 2;
    f32x16 o[4];
#pragma unroll
    for (int d = 0; d < 4; ++d)
#pragma unroll
        for (int r = 0; r < 16; ++r) o[d][r] = 0.f;
    float m = -1.0e30f, l = 0.f;
    const float c2 = 0.125f * LOG2E, sl2 = exp2f(-2.0f * (float)(h + 1)) * LOG2E;
    const float qpos = (float)(q0 + r32 - 4 * hi);
    u32x4 ks_[2], vs_[2];
    tile_gload<16>(ks_, kg, gp, tid); tile_gload<16>(vs_, vg, gp, tid);
    for (int t = 0; t < NT; ++t) {
        __syncthreads();
        tile_swrite<16, KP>(ks_, lds + ALDS_K, tid); tile_swrite<16, VP>(vs_, lds + ALDS_V, tid);
        __syncthreads();
        if (t + 1 < NT) { tile_gload<16>(ks_, kg + (size_t)(t + 1) * 64 * gp, gp, tid); tile_gload<16>(vs_, vg + (size_t)(t + 1) * 64 * gp, gp, tid); }
        f32x16 p0, p1;
        qk_tile<64, KP>(p0, p1, lds + ALDS_K + map * 128, qf, r32, hi);
        const float dq = qpos - (float)(t * 64);
#pragma unroll
        for (int r = 0; r < 16; ++r) { const float kr = (float)((r & 3) + 8 * (r >> 2));
            p0[r] = p0[r] * c2 - sl2 * fabsf(dq - kr); p1[r] = p1[r] * c2 - sl2 * fabsf(dq - (kr + 32.f)); }
        softmax_pv<128, VP>(p0, p1, o, m, l, lds + ALDS_V, lane);
    }
    l += __shfl_xor(l, 32);
    const float inv = (map ? lam : 1.0f) / l;
    LAS f32x4* xch = (LAS f32x4*)(lds + ALDS_X + (wid & 3) * 16384) + lane;
    if (map) {
#pragma unroll
        for (int d = 0; d < 4; ++d)
#pragma unroll
            for (int g = 0; g < 4; ++g) xch[(d * 4 + g) * 64] = (f32x4){o[d][4 * g] * inv, o[d][4 * g + 1] * inv, o[d][4 * g + 2] * inv, o[d][4 * g + 3] * inv};
    }
    __syncthreads();
    if (!map) {
        float ss = 0.f;
#pragma unroll
        for (int d = 0; d < 4; ++d)
#pragma unroll
            for (int g = 0; g < 4; ++g) { const f32x4 x2 = xch[(d * 4 + g) * 64];
#pragma unroll
                for (int i = 0; i < 4; ++i) { const float v = o[d][4 * g + i] * inv - x2[i]; o[d][4 * g + i] = v; ss += v * v; } }
        ss += __shfl_xor(ss, 32);
        const float rn = __builtin_amdgcn_rsqf(ss * (1.0f / 128.0f) + EPS) * 0.8f;
        bf16_t* orow = A.att + (rowb + q0 + r32) * ATTW + 512 + h * 128;
#pragma unroll
        for (int d = 0; d < 4; ++d)
#pragma unroll
            for (int g = 0; g < 4; ++g) { const f32x4 sg = *(const f32x4*)(A.subln + 32 * d + 8 * g + 4 * hi); u32x2 w;
                w.x = cvtpk(o[d][4 * g] * rn * sg[0], o[d][4 * g + 1] * rn * sg[1]); w.y = cvtpk(o[d][4 * g + 2] * rn * sg[2], o[d][4 * g + 3] * rn * sg[3]);
                *(u32x2*)(orow + 32 * d + 8 * g + 4 * hi) = w; }
    }
}
DEV void na_unit(const AttnArgs& A, LAS char* lds, int b, int r, int hg) {
    constexpr int KP = 528, VP = 576;
    const int tid = threadIdx.x, lane = tid & 63, r32 = lane & 31, hi = lane >> 5, wid = __builtin_amdgcn_readfirstlane(tid >> 6), hh = wid >> 1, head = hg * 4 + hh;
    const size_t rowb = (size_t)b * SEQ; const int c = (wid & 1) * 32 + r32;
    const bf16_t* qp = A.proj + (rowb + r * 64 + c) * INW + O_NQ + head * 64 + hi * 8;
    bf16x8 qf[4];
#pragma unroll
    for (int ks = 0; ks < 4; ++ks) qf[ks] = *(const bf16x8*)(qp + ks * 16);
    const int rs = min(max(r - 4, 0), 24), cs = min(max(c - 8, 0), 48);
    const char* kg = (const char*)(A.proj + (rowb + rs * 64) * INW + O_NK + hg * 256); const char* vg = (const char*)(A.proj + (rowb + rs * 64) * INW + O_NV + hg * 256);
    const size_t gp = (size_t)INW * 2;
    const LAS float* tab = (const LAS float*)(lds + ALDS_X) + head * 465;
    f32x16 o[2];
#pragma unroll
    for (int d = 0; d < 2; ++d)
#pragma unroll
        for (int rr = 0; rr < 16; ++rr) o[d][rr] = 0.f;
    float m = -1.0e30f, l = 0.f; const float c2 = 0.125f * LOG2E;
    u32x4 ks_[4], vs_[4];
    tile_gload<32>(ks_, kg, gp, tid); tile_gload<32>(vs_, vg, gp, tid);
    for (int j = 0; j < 8; ++j) {
        __syncthreads();
        tile_swrite<32, KP>(ks_, lds + ALDS_K, tid); tile_swrite<32, VP>(vs_, lds + ALDS_V, tid);
        __syncthreads();
        if (j + 1 < 8) { tile_gload<32>(ks_, kg + (size_t)(j + 1) * 64 * gp, gp, tid); tile_gload<32>(vs_, vg + (size_t)(j + 1) * 64 * gp, gp, tid); }
        f32x16 p0, p1;
        qk_tile<64, KP>(p0, p1, lds + ALDS_K + hh * 128, qf, r32, hi);
        const int dr = rs + j - r + 7; const LAS float* trow = tab + dr * 31 + 15 - c;
#pragma unroll
        for (int rr = 0; rr < 16; ++rr) {
            const int kc0 = crow(rr, hi), kc1 = kc0 + 32;
            const bool v0 = (unsigned)(kc0 - cs) < 16u, v1 = (unsigned)(kc1 - cs) < 16u;
            const float b0 = trow[v0 ? kc0 : c], b1 = trow[v1 ? kc1 : c];
            p0[rr] = v0 ? p0[rr] * c2 + b0 : NEG_BIG; p1[rr] = v1 ? p1[rr] * c2 + b1 : NEG_BIG;
        }
        softmax_pv<64, VP>(p0, p1, o, m, l, lds + ALDS_V + hh * 128, lane);
    }
    l += __shfl_xor(l, 32);
    store_ot<64>(o, 1.0f / l, A.att + (rowb + r * 64 + c) * ATTW + head * 64, hi);
}
DEV void mem_unit(const AttnArgs& A, LAS char* lds, int b, int h, int qb) {
    constexpr int KP = 272, VP = 320;
    const int tid = threadIdx.x, lane = tid & 63, r32 = lane & 31, hi = lane >> 5, wid = __builtin_amdgcn_readfirstlane(tid >> 6);
    const size_t row = (size_t)b * SEQ + qb * 256 + wid * 32 + r32;
    const bf16_t* qp = A.proj + row * INW + O_MQ + h * 128 + hi * 8;
    bf16x8 qf[8];
#pragma unroll
    for (int ks = 0; ks < 8; ++ks) qf[ks] = *(const bf16x8*)(qp + ks * 16);
    const char* kg = (const char*)(A.mkv + (size_t)b * MEMT * 1024 + h * 128); const char* vg = kg + 512 * 2;
    const size_t gp = 1024 * 2;
    f32x16 o[4];
#pragma unroll
    for (int d = 0; d < 4; ++d)
#pragma unroll
        for (int rr = 0; rr < 16; ++rr) o[d][rr] = 0.f;
    float m = -1.0e30f, l = 0.f; const float c2 = 0.08838834764831845f * LOG2E;
    u32x4 ks_[2], vs_[2];
    tile_gload<16>(ks_, kg, gp, tid); tile_gload<16>(vs_, vg, gp, tid);
    for (int t = 0; t < 4; ++t) {
        __syncthreads();
        tile_swrite<16, KP>(ks_, lds + ALDS_K, tid); tile_swrite<16, VP>(vs_, lds + ALDS_V, tid);
        __syncthreads();
        if (t + 1 < 4) { tile_gload<16>(ks_, kg + (size_t)(t + 1) * 64 * gp, gp, tid); tile_gload<16>(vs_, vg + (size_t)(t + 1) * 64 * gp, gp, tid); }
        f32x16 p0, p1;
        qk_tile<128, KP>(p0, p1, lds + ALDS_K, qf, r32, hi);
#pragma unroll
        for (int rr = 0; rr < 16; ++rr) { p0[rr] *= c2; p1[rr] *= c2; }
        softmax_pv<128, VP>(p0, p1, o, m, l, lds + ALDS_V, lane);
    }
    l += __shfl_xor(l, 32);
    store_ot<128>(o, 1.0f / l, A.att + row * ATTW + 1024 + h * 128, hi);
}
DEV void attention_phase(const AttnArgs& A, LAS char* lds, int c, int G, int dup) {
    const int lane = threadIdx.x & 63;
    const float lam = __expf(wave_sum(A.lq1[lane] * A.lk1[lane])) - __expf(wave_sum(A.lq2[lane] * A.lk2[lane])) + 0.2f;
    for (int uu = c; uu < dup * NB * 4 * 16; uu += G) { const int u = uu & 511; diff_unit(A, lds, u >> 6, (u >> 4) & 3, u & 15, lam); }
    __syncthreads();
    for (int i = threadIdx.x; i < 8 * 15 * 31; i += NTHR) ((LAS float*)(lds + ALDS_X))[i] = A.rpb[i] * LOG2E;
    for (int uu = c; uu < dup * NB * 32 * 2; uu += G) { const int u = uu & 511; na_unit(A, lds, u >> 6, (u >> 1) & 31, u & 1); }
    for (int uu = c; uu < dup * NB * 4 * 8; uu += G) { const int u = uu & 255; mem_unit(A, lds, u >> 5, (u >> 3) & 3, u & 7); }
}


#define XB_TMO      128
#define XB_XCNT(j)  (256  + 64 * (j))
#define XB_XSUB(j)  (1280 + 64 * (j))
#define XB_XGEN(j)  (2304 + 64 * (j))
#define XB_TOP      3328
#define XB_TOPGEN   3392
#define XCD_BAR_WORDS 3456
#define XB_SPIN_CAP (1u << 18)

__device__ __forceinline__ unsigned xb_ld(unsigned* p)              { return __hip_atomic_load(p, __ATOMIC_RELAXED, __HIP_MEMORY_SCOPE_AGENT); }
__device__ __forceinline__ unsigned xb_add(unsigned* p, unsigned v) { return __hip_atomic_fetch_add(p, v, __ATOMIC_RELAXED, __HIP_MEMORY_SCOPE_AGENT); }
__device__ __forceinline__ unsigned xb_xcc_id() { return (unsigned)__builtin_amdgcn_s_getreg((3 << 11) | 20) & 0xFu; }
#define XB_SPIN(cond, bar) do { unsigned _sp = 0; while (cond) { __builtin_amdgcn_s_sleep(1); \
    if ((++_sp & 255u) == 0u) { if (xb_ld(&(bar)[XB_TMO])) break; if (_sp > XB_SPIN_CAP) { atomicAdd(&(bar)[XB_TMO], 1u); break; } } } } while (0)

struct XcdBarrier {
    unsigned* bar; unsigned x;
    volatile LAS unsigned* st;
};

__device__ __forceinline__ XcdBarrier xcd_barrier_post(unsigned* bar, volatile LAS unsigned* st) {
    XcdBarrier b; b.bar = bar; b.x = xb_xcc_id(); b.st = st;
    if (threadIdx.x == 0) (void)xb_add(&bar[XB_XCNT(b.x)], 1u);
    return b;
}
__device__ __forceinline__ void xcd_barrier_complete(unsigned* bar, unsigned x, unsigned& nloc, unsigned& nx) {
    const unsigned G = gridDim.x * gridDim.y * gridDim.z;
    unsigned sum, cnt, mine, sp = 0u;
    for (;;) {
        sum = 0u; cnt = 0u; mine = 0u;
#pragma unroll
        for (unsigned j = 0; j < 16; ++j) { const unsigned c = xb_ld(&bar[XB_XCNT(j)]); sum += c; cnt += (c > 0u) ? 1u : 0u; mine = (j == x) ? c : mine; }
        if (sum == G) break;
        __builtin_amdgcn_s_sleep(1);
        if ((++sp & 255u) == 0u) { if (xb_ld(&bar[XB_TMO])) break; if (sp > XB_SPIN_CAP) { atomicAdd(&bar[XB_TMO], 1u); break; } }
    }
    nloc = mine > 0u ? mine : 1u; nx = cnt > 0u ? cnt : 1u;
}

__device__ __forceinline__ void xcd_barrier(const XcdBarrier& b) {
    asm volatile("s_waitcnt vmcnt(0)" ::: "memory");
    __syncthreads();
    if (threadIdx.x == 0) {
        unsigned* bar = b.bar;
        __builtin_amdgcn_s_waitcnt(0);
        unsigned nloc = b.st[0], nx = b.st[1];
        if (nloc == 0u) { xcd_barrier_complete(bar, b.x, nloc, nx); b.st[0] = nloc; b.st[1] = nx; }
        const unsigned old = xb_add(&bar[XB_XSUB(b.x)], 1u);
        const unsigned gen = old / nloc;
        if (old + 1u == (gen + 1u) * nloc) {
            __builtin_amdgcn_fence(__ATOMIC_RELEASE, "agent");
            asm volatile("s_waitcnt vmcnt(0)" ::: "memory");
            const unsigned og = xb_add(&bar[XB_TOP], 1u);
            const unsigned tg = og / nx;
            if (og + 1u == (tg + 1u) * nx) xb_add(&bar[XB_TOPGEN], 1u);
            else XB_SPIN(xb_ld(&bar[XB_TOPGEN]) == tg, bar);
            __builtin_amdgcn_fence(__ATOMIC_ACQUIRE, "agent");
            xb_add(&bar[XB_XGEN(b.x)], 1u);
            asm volatile("s_waitcnt vmcnt(0)" ::: "memory");
        } else {
            XB_SPIN(xb_ld(&bar[XB_XGEN(b.x)]) == gen, bar);
            __builtin_amdgcn_fence(__ATOMIC_ACQUIRE, "agent");
            asm volatile("s_waitcnt vmcnt(0)" ::: "memory");
        }
    }
    __syncthreads();
}


struct Args { const float* in[27]; float* out; unsigned char* ws; int ph_lo, ph_hi, coop, pad; };

__global__ void __launch_bounds__(NTHR, 2) fwd_megakernel(Args a) {
    extern __shared__ __attribute__((aligned(16))) unsigned char lds_raw[];
    LAS unsigned char* lds = (LAS unsigned char*)lds_raw;
    cg::grid_group grid = cg::this_grid();
    const int tid = threadIdx.x, lane = tid & 63, wave = __builtin_amdgcn_readfirstlane(tid >> 6);
    const int G = gridDim.x, c = blockIdx.x;
    unsigned char* ws = a.ws;
    const float *x = a.in[0], *mem = a.in[1], *ffn1_norm = a.in[2], *ffn1_wg = a.in[3], *ffn1_wu = a.in[4], *ffn1_wd = a.in[5], *mix_norm = a.in[6], *w_in = a.in[7], *na_rpb = a.in[8],
                *lq1 = a.in[9], *lk1 = a.in[10], *lq2 = a.in[11], *lk2 = a.in[12], *subln = a.in[13], *mem_norm = a.in[14], *w_mem_kv = a.in[15], *w_gate = a.in[16], *b_gate = a.in[17],
                *w_br_na = a.in[18], *w_br_diff = a.in[19], *w_br_mem = a.in[20], *w_out = a.in[21], *ffn2_norm = a.in[22], *ffn2_wg = a.in[23], *ffn2_wu = a.in[24], *ffn2_wd = a.in[25], *final_norm = a.in[26];
    bf16_t *W1T = (bf16_t*)(ws + WS_W1T), *WD1T = (bf16_t*)(ws + WS_WD1T), *WMIX = (bf16_t*)(ws + WS_WMIX), *WBR = (bf16_t*)(ws + WS_WBR), *WOUT = (bf16_t*)(ws + WS_WOUT),
           *W2T = (bf16_t*)(ws + WS_W2T), *WD2T = (bf16_t*)(ws + WS_WD2T), *XB = (bf16_t*)(ws + WS_XB), *MKV = (bf16_t*)(ws + WS_MKV), *HID = (bf16_t*)(ws + WS_HID),
           *PROJ = (bf16_t*)(ws + WS_PROJ), *GATES = (bf16_t*)(ws + WS_GATES), *ATT = (bf16_t*)(ws + WS_ATT), *X2B = (bf16_t*)(ws + WS_X2B);
    float* SSQ = (float*)(ws + WS_SSQ); float* out = a.out;
    const int lo = a.ph_lo, hi = a.ph_hi;
    volatile LAS unsigned* bst = (volatile LAS unsigned*)(lds + LDS_MISC);
    if (tid < 16) bst[tid] = 0u;
    __syncthreads();
    XcdBarrier bar; bar.bar = (unsigned*)(ws + WS_CTL); bar.x = 0; bar.st = bst;
    if (a.coop) bar = xcd_barrier_post((unsigned*)(ws + WS_CTL), bst);
    if (a.coop == 2) grid.sync();
#define IN(k) (lo <= (k) && (k) < hi)
#define SEAM(k) do { if (IN(k) && IN((k) + 1)) { if (a.coop) xcd_barrier(bar); } } while (0)

    if (IN(0)) {
        LAS float* scr = (LAS float*)(lds + wave * 16384);
        const int gw = c * NWAVES + wave, ngw = G * NWAVES;
        transpose_matrix<1>(ffn1_wg, D, FF, W1T, 0, ffn1_norm, scr, gw, ngw, lane);
        transpose_matrix<2>(ffn1_wu, D, FF, W1T, 0, ffn1_norm, scr, gw, ngw, lane);
        transpose_matrix<0>(ffn1_wd, FF, D, WD1T, 0, nullptr, scr, gw, ngw, lane);
        transpose_matrix<0>(w_in, D, INW, WMIX, 0, mix_norm, scr, gw, ngw, lane);
        transpose_matrix<0>(w_gate, D, GW, WMIX, INW, mix_norm, scr, gw, ngw, lane);
        transpose_matrix<0>(w_mem_kv, D, 1024, WMIX, INW + GW, mem_norm, scr, gw, ngw, lane);
        transpose_matrix<0>(w_br_na, 512, D, WBR, 0, nullptr, scr, gw, ngw, lane);
        transpose_matrix<0>(w_br_diff, 512, D, WBR, D, nullptr, scr, gw, ngw, lane);
        transpose_matrix<0>(w_br_mem, 512, D, WBR, 2 * D, nullptr, scr, gw, ngw, lane);
        transpose_matrix<0>(w_out, D, D, WOUT, 0, nullptr, scr, gw, ngw, lane);
        transpose_matrix<1>(ffn2_wg, D, FF, W2T, 0, ffn2_norm, scr, gw, ngw, lane);
        transpose_matrix<2>(ffn2_wu, D, FF, W2T, 0, ffn2_norm, scr, gw, ngw, lane);
        transpose_matrix<0>(ffn2_wd, FF, D, WD2T, 0, nullptr, scr, gw, ngw, lane);
        for (int r0 = gw; r0 < DUPF(0) * (M + MEMR); r0 += 2 * ngw) {
            const int rA = r0 >= M + MEMR ? r0 - (M + MEMR) : r0, r1 = r0 + ngw; const bool two = r1 < DUPF(0) * (M + MEMR); const int rB = r1 >= M + MEMR ? r1 - (M + MEMR) : r1;
            const float* pA = rA < M ? x + (size_t)rA * D : mem + (size_t)(rA - M) * D; const float* pB = rB < M ? x + (size_t)rB * D : mem + (size_t)(rB - M) * D;
            f32x4 va[4], vb[4];
#pragma unroll
            for (int j = 0; j < 4; ++j) va[j] = ((const f32x4*)pA)[lane + 64 * j];
            if (two) {
#pragma unroll
                for (int j = 0; j < 4; ++j) vb[j] = ((const f32x4*)pB)[lane + 64 * j];
            }
            rowv_to_bf16(va, XB + (size_t)rA * D, SSQ + (size_t)rA * 16, lane);
            if (two) rowv_to_bf16(vb, XB + (size_t)rB * D, SSQ + (size_t)rB * 16, lane);
        }
    }
    SEAM(0);
    if (IN(1)) {
        pg8::SchedRect S; S.so.init(M, 2 * FF); S.A = (const char*)XB; S.B = (const char*)W1T; S.at = (size_t)256 * D * 2; S.bt = (size_t)256 * D * 2; S.G = G; S.c = c; S.dup = DUPF(1);
        pg8::EpiSwiglu E{HID, SSQ};
        pg8::gemm_phase(lds, D, D, D, S, E);
    }
    SEAM(1);
    if (IN(2)) {
        pg8::SchedRect S; S.so.init(M, D); S.A = (const char*)HID; S.B = (const char*)WD1T; S.at = (size_t)256 * FF * 2; S.bt = (size_t)256 * FF * 2; S.G = G; S.c = c; S.dup = DUPF(2);
        pg8::EpiResid E{x, out, XB, SSQ, 0.5f};
        pg8::gemm_phase(lds, FF, FF, FF, S, E);
    }
    SEAM(2);
    if (IN(3)) {
        pg8::SchedP3 S; S.so.init(M, INW); S.A = (const char*)XB; S.B = (const char*)WMIX; S.at = (size_t)256 * D * 2; S.bt = (size_t)256 * D * 2; S.G = G; S.c = c; S.dup = DUPF(3);
        pg8::EpiProj E{PROJ, MKV, SSQ};
        pg8::gemm_phase(lds, D, D, D, S, E);
    }
    SEAM(3);
    if (IN(4)) {
        const AttnArgs A{PROJ, MKV, ATT, na_rpb, lq1, lk1, lq2, lk2, subln};
        attention_phase(A, (LAS char*)lds, c, G, DUPF(4));
    }
    SEAM(4);
    if (IN(5)) {
        pg8::SchedRect S; S.so.init(M, GW); S.A = (const char*)XB; S.B = (const char*)(WMIX + (size_t)INW * D); S.at = (size_t)256 * D * 2; S.bt = (size_t)256 * D * 2; S.G = G; S.c = c; S.dup = DUPF(5);
        pg8::EpiGate E{GATES, SSQ, b_gate};
        pg8::gemm_phase(lds, D, D, D, S, E);
    }
    SEAM(5);
    if (IN(6)) {
        pg8::SchedBr S; S.so.init(M, D); S.A = (const char*)ATT; S.B = (const char*)WBR; S.at = (size_t)256 * ATTW * 2; S.bt = (size_t)256 * 512 * 2; S.G = G; S.c = c; S.dup = DUPF(6);
        pg8::EpiMerge E{XB, GATES};
        pg8::gemm_phase(lds, 512, ATTW, 512, S, E);
    }
    SEAM(6);
    if (IN(7)) {
        pg8::SchedRect S; S.so.init(M, D); S.A = (const char*)XB; S.B = (const char*)WOUT; S.at = (size_t)256 * D * 2; S.bt = (size_t)256 * D * 2; S.G = G; S.c = c; S.dup = 1;
        pg8::EpiResid E{out, out, X2B, SSQ, 1.0f};
        pg8::gemm_phase(lds, D, D, D, S, E);
    }
    SEAM(7);
    if (IN(8)) {
        pg8::SchedRect S; S.so.init(M, 2 * FF); S.A = (const char*)X2B; S.B = (const char*)W2T; S.at = (size_t)256 * D * 2; S.bt = (size_t)256 * D * 2; S.G = G; S.c = c; S.dup = DUPF(8);
        pg8::EpiSwiglu E{HID, SSQ};
        pg8::gemm_phase(lds, D, D, D, S, E);
    }
    SEAM(8);
    if (IN(9)) {
        pg8::SchedRect S; S.so.init(M, D); S.A = (const char*)HID; S.B = (const char*)WD2T; S.at = (size_t)256 * FF * 2; S.bt = (size_t)256 * FF * 2; S.G = G; S.c = c; S.dup = 1;
        pg8::EpiResid E{out, out, nullptr, SSQ, 0.5f};
        pg8::gemm_phase(lds, FF, FF, FF, S, E);
    }
    SEAM(9);
    if (a.coop) for (int i_ = 0; i_ < PROBE_SYNCS; ++i_) xcd_barrier(bar);
    if (IN(10)) {
        const int gw = c * NWAVES + wave, ngw = G * NWAVES;
        f32x4 gn[4];
#pragma unroll
        for (int j = 0; j < 4; ++j) gn[j] = ((const f32x4*)final_norm)[lane + 64 * j];
        for (int r = gw; r < M; r += ngw) {
            const float rs = row_rstd(SSQ, r); f32x4* p = (f32x4*)(out + (size_t)r * D) + lane;
#pragma unroll
            for (int j = 0; j < 4; ++j) p[64 * j] = p[64 * j] * rs * gn[j];
        }
    }
#undef IN
#undef SEAM
}

extern "C" void kernel_launch(void* const* d_in, const int* in_sizes, int n_in, void* d_out, int out_size, void* d_ws, size_t ws_size, hipStream_t stream) {
    static int grid = 0;
    if (grid == 0) {
        if (n_in != 27 || out_size != M * D || ws_size < WS_END) { fprintf(stderr, "kernel_launch: unexpected problem (n_in %d out %d ws %zu)\n", n_in, out_size, ws_size); grid = -1; return; }
        int dev = 0, cus = 0, per_cu = 0;
        hipGetDevice(&dev); hipDeviceGetAttribute(&cus, hipDeviceAttributeMultiprocessorCount, dev);
        hipFuncSetAttribute((const void*)fwd_megakernel, hipFuncAttributeMaxDynamicSharedMemorySize, LDS_BYTES);
        if (hipOccupancyMaxActiveBlocksPerMultiprocessor(&per_cu, (const void*)fwd_megakernel, NTHR, LDS_BYTES) != hipSuccess || per_cu < 1) { fprintf(stderr, "kernel_launch: occupancy query says %d\n", per_cu); per_cu = 1; }
        (void)hipGetLastError();
        grid = cus * (per_cu > 1 ? 1 : per_cu);
    }
    if (grid < 0) return;
    Args a{};
    for (int i = 0; i < 27; ++i) a.in[i] = (const float*)d_in[i];
    a.out = (float*)d_out; a.ws = (unsigned char*)d_ws;
    if (MK_N_LAUNCHES == 1) {
        if (hipMemsetAsync((char*)d_ws + WS_CTL, 0, CTL_BYTES, stream) != hipSuccess) { fprintf(stderr, "kernel_launch: memset of the barrier words failed\n"); return; }
        a.ph_lo = 0; a.ph_hi = 11; a.coop = 1;
        void* args[] = {&a};
        hipError_t e = hipLaunchCooperativeKernel((const void*)fwd_megakernel, dim3(grid), dim3(NTHR), args, LDS_BYTES, stream);
        if (e != hipSuccess) fprintf(stderr, "cooperative launch failed: %s (grid %d)\n", hipGetErrorString(e), grid);
    } else {
        for (int p = 0; p < 11; ++p) { a.ph_lo = p; a.ph_hi = p + 1; a.coop = 0; hipLaunchKernelGGL(fwd_megakernel, dim3(grid), dim3(NTHR), LDS_BYTES, stream, a); }
    }
}
```

```cpp
#include <hip/hip_runtime.h>
#include <hip/hip_cooperative_groups.h>
#include <cstdio>
#include <cstdint>
namespace cg = cooperative_groups;

#ifndef MK_N_LAUNCHES
#define MK_N_LAUNCHES 1
#endif

#ifndef PROBE_DUP
#define PROBE_DUP 0
#endif
#ifndef PROBE_SYNCS
#define PROBE_SYNCS 0
#endif
#define DUPF(k) (1 + ((PROBE_DUP >> (k)) & 1))

#define LAS __attribute__((address_space(3)))
#define DEV __device__ __forceinline__
typedef unsigned short bf16_t;
typedef short bf16x8 __attribute__((ext_vector_type(8)));
typedef short s16x4 __attribute__((ext_vector_type(4)));
typedef float f32x2 __attribute__((ext_vector_type(2)));
typedef float f32x4 __attribute__((ext_vector_type(4)));
typedef float f32x16 __attribute__((ext_vector_type(16)));
typedef unsigned u32x2 __attribute__((ext_vector_type(2)));
typedef unsigned u32x4 __attribute__((ext_vector_type(4)));
typedef __bf16 bf16x2_t __attribute__((ext_vector_type(2)));

constexpr int M = 16384, D = 1024, FF = 2816, INW = 3584, GW = 3072, SEQ = 2048, NB = 8, MEMT = 256, MEMR = NB * MEMT;
constexpr int O_NQ = 0, O_NK = 512, O_NV = 1024, O_DQ = 1536, O_DK = 2048, O_DV = 2560, O_MQ = 3072;
constexpr int ATTW = 1536;
constexpr float EPS = 1e-6f, LOG2E = 1.4426950408889634f;
constexpr int NTHR = 512, NWAVES = 8;
constexpr int LDS_BYTES = 147456, LDS_MISC = LDS_BYTES - 64;

constexpr size_t MiB = 1u << 20;
constexpr size_t WS_W1T = 0, WS_WD1T = 11 * MiB, WS_WMIX = WS_WD1T + 11 * MiB / 2, WS_WBR = WS_WMIX + 15 * MiB, WS_WOUT = WS_WBR + 3 * MiB,
                 WS_W2T = WS_WOUT + 2 * MiB, WS_WD2T = WS_W2T + 11 * MiB, WS_XB = 53 * MiB, WS_SSQ = 89 * MiB, WS_MKV = 91 * MiB, WS_OV = 96 * MiB;
constexpr size_t WS_CTL = 95 * MiB, CTL_BYTES = 16384;
constexpr size_t WS_HID = WS_OV, WS_PROJ = WS_OV, WS_GATES = WS_OV, WS_ATT = 208 * MiB, WS_X2B = 208 * MiB, WS_END = 256 * MiB;
static_assert(WS_WD2T + 11 * MiB / 2 == WS_XB, "weights end at 53 MiB");
static_assert(WS_PROJ + (size_t)M * INW * 2 == WS_ATT && WS_ATT + (size_t)M * ATTW * 2 == WS_END, "overlay map");

DEV unsigned cvtpk(float lo, float hi) { f32x2 v = {lo, hi}; bf16x2_t b = __builtin_convertvector(v, bf16x2_t); return __builtin_bit_cast(unsigned, b); }
DEV float bf_lo(unsigned w) { return __uint_as_float(w << 16); }
DEV float bf_hi(unsigned w) { return __uint_as_float(w & 0xffff0000u); }
DEV float wave_sum(float v) {
#pragma unroll
    for (int o = 1; o < 64; o <<= 1) v += __shfl_xor(v, o);
    return v;
}
DEV float row_rstd(const float* ssq, int row) {
    const f32x4* p = (const f32x4*)(ssq + (size_t)row * 16);
    const f32x4 a = p[0], b = p[1], c = p[2], d = p[3];
    const float s = ((a[0] + a[1]) + (a[2] + a[3])) + ((b[0] + b[1]) + (b[2] + b[3])) + ((c[0] + c[1]) + (c[2] + c[3])) + ((d[0] + d[1]) + (d[2] + d[3]));
    return __builtin_amdgcn_rsqf(s * (1.0f / D) + EPS);
}

namespace pg8 {
constexpr int BM = 256, BK = 64, HALF = 128, HTB = HALF * BK * 2, STAGE_BYTES = 8 * HTB, NXCD = 8, WGM = 8;
__host__ __device__ __forceinline__ int lds_byte(int r, int c) { const int st = (r >> 4) * 2 + (c >> 5), rr = r & 15, cc = c & 31, ob = rr * 64 + cc * 2; return st * 1024 + (ob ^ (((ob >> 9) & 1) << 5)); }
__host__ __device__ __forceinline__ void stage_rc(int b, int& R, int& C) { const int st = b / 1024, sb = b % 1024, swz = sb ^ (((sb >> 9) & 1) << 5); R = (st >> 1) * 16 + swz / 64; C = (st & 1) * 32 + (swz % 64) / 2; }
__host__ __device__ __forceinline__ int perm32(int rho) { const int n = rho >> 4, i = rho & 15; return 8 * (i >> 2) + 4 * n + (i & 3); }

struct Unit { int pm, pn, br; };

struct StaticOrder {
    int nM, nN, nwg;
    __device__ void init(int M_, int N_) { nM = M_ / BM; nN = N_ / BM; nwg = nM * nN; }
    __device__ void map(int L, Unit& u) const {
        int wgid = L; { const int q = nwg / NXCD, r = nwg % NXCD, xcd = wgid % NXCD, off = wgid / NXCD; wgid = (xcd < r ? xcd * (q + 1) : r * (q + 1) + (xcd - r) * q) + off; }
        const int nig = WGM * nN, gid = wgid / nig, fm = gid * WGM, gsz = (nM - fm) < WGM ? (nM - fm) : WGM;
        u.pm = fm + ((wgid % nig) % gsz); u.pn = (wgid % nig) / gsz; u.br = 0;
    }
};
struct SchedRect {
    StaticOrder so; const char* A; const char* B; size_t at, bt; int G, c, dup;
    DEV bool next(int i, Unit& u) const { int L = i * G + c; if (L >= dup * so.nwg) return false; if (L >= so.nwg) L -= so.nwg; so.map(L, u); return true; }
    DEV const char* aptr(const Unit& u) const { return A + (size_t)u.pm * at; }
    DEV const char* bptr(const Unit& u) const { return B + (size_t)u.pn * bt; }
};
struct SchedP3 {
    StaticOrder so; const char* A; const char* B; size_t at, bt; int G, c, dup;
    DEV bool next(int i, Unit& u) const {
        int L = i * G + c; if (dup > 1 && L >= so.nwg + 32) L -= so.nwg + 32;
        if (L < so.nwg) { so.map(L, u); return true; }
        const int e = L - so.nwg; if (e >= 32) return false;
        u.pm = 64 + (e >> 2); u.pn = 26 + (e & 3); u.br = 0; return true;
    }
    DEV const char* aptr(const Unit& u) const { return A + (size_t)u.pm * at; }
    DEV const char* bptr(const Unit& u) const { return B + (size_t)u.pn * bt; }
};
struct SchedBr {
    StaticOrder so; const char* A; const char* B; size_t at, bt; int G, c, dup;
    DEV bool next(int i, Unit& u) const { int L = (i / 3) * G + c; if (L >= dup * so.nwg) return false; if (L >= so.nwg) L -= so.nwg; so.map(L, u); u.br = i % 3; return true; }
    DEV const char* aptr(const Unit& u) const { return A + (size_t)u.pm * at + (size_t)u.br * 512 * 2; }
    DEV const char* bptr(const Unit& u) const { return B + ((size_t)u.br * 4 + u.pn) * bt; }
};

typedef f32x4 Acc[2][2][4][2];

DEV float silu_mul(float g, float u) { return g * u * __builtin_amdgcn_rcpf(1.0f + __builtin_amdgcn_exp2f(-LOG2E * g)); }
DEV float sigm(float v) { return __builtin_amdgcn_rcpf(1.0f + __builtin_amdgcn_exp2f(-LOG2E * v)); }

struct EpiSwiglu {
    static constexpr bool PERM = true;
    bf16_t* H; const float* ssq;
    DEV void operator()(const Acc& acc, const Unit& u, int wr, int wc, int fr, int fq) const {
        const int row0 = u.pm * BM + wr * 64 + fr, col0 = u.pn * 128 + wc * 32 + 8 * fq;
#pragma unroll
        for (int ai = 0; ai < 2; ++ai)
#pragma unroll
            for (int m = 0; m < 4; ++m) {
                const int row = row0 + ai * HALF + m * 16; const float rs = row_rstd(ssq, row);
                const f32x4 g0 = acc[ai][0][m][0] * rs, g1 = acc[ai][0][m][1] * rs, u0 = acc[ai][1][m][0] * rs, u1 = acc[ai][1][m][1] * rs;
                u32x4 w;
                w.x = cvtpk(silu_mul(g0[0], u0[0]), silu_mul(g0[1], u0[1])); w.y = cvtpk(silu_mul(g0[2], u0[2]), silu_mul(g0[3], u0[3]));
                w.z = cvtpk(silu_mul(g1[0], u1[0]), silu_mul(g1[1], u1[1])); w.w = cvtpk(silu_mul(g1[2], u1[2]), silu_mul(g1[3], u1[3]));
                *(u32x4*)(H + (size_t)row * FF + col0) = w;
            }
    }
};
struct EpiResid {
    static constexpr bool PERM = false;
    const float* base; float* out; bf16_t* xb; float* ssq; float s;
    DEV void operator()(const Acc& acc, const Unit& u, int wr, int wc, int fr, int fq) const {
        const int row0 = u.pm * BM + wr * 64 + fr, col0 = u.pn * BM + wc * 32 + 4 * fq;
#pragma unroll
        for (int ai = 0; ai < 2; ++ai)
#pragma unroll
            for (int m = 0; m < 4; ++m) {
                const int row = row0 + ai * HALF + m * 16; const size_t off = (size_t)row * D + col0; float q = 0.f;
#pragma unroll
                for (int bj = 0; bj < 2; ++bj)
#pragma unroll
                    for (int n = 0; n < 2; ++n) {
                        const f32x4 b = *(const f32x4*)(base + off + bj * HALF + n * 16);
                        const f32x4 v = b + acc[ai][bj][m][n] * s;
                        *(f32x4*)(out + off + bj * HALF + n * 16) = v;
                        if (xb) { u32x2 w; w.x = cvtpk(v[0], v[1]); w.y = cvtpk(v[2], v[3]); *(u32x2*)(xb + off + bj * HALF + n * 16) = w; }
                        q += (v[0] * v[0] + v[1] * v[1]) + (v[2] * v[2] + v[3] * v[3]);
                    }
                q += __shfl_xor(q, 16); q += __shfl_xor(q, 32);
                if (fq == 0) ssq[(size_t)row * 16 + u.pn * 4 + wc] = q;
                asm volatile("" ::: "memory");
            }
    }
};
struct EpiProj {
    static constexpr bool PERM = true;
    bf16_t* P; bf16_t* MKV; const float* ssq;
    DEV void operator()(const Acc& acc, const Unit& u, int wr, int wc, int fr, int fq) const {
        const int row0 = u.pm * BM + wr * 64 + fr; const bool mem = u.pm >= 64;
        bf16_t* base = mem ? MKV + (size_t)(row0 - M) * 1024 + (u.pn - 26) * BM : P + (size_t)row0 * INW + u.pn * BM;
        const size_t ldc = mem ? 1024 : INW; base += wc * 32 + 8 * fq;
#pragma unroll
        for (int ai = 0; ai < 2; ++ai)
#pragma unroll
            for (int m = 0; m < 4; ++m) {
                const int row = row0 + ai * HALF + m * 16; const float rs = row_rstd(ssq, row);
                bf16_t* rp = base + (size_t)(ai * HALF + m * 16) * ldc;
#pragma unroll
                for (int bj = 0; bj < 2; ++bj) {
                    const f32x4 v0 = acc[ai][bj][m][0] * rs, v1 = acc[ai][bj][m][1] * rs; u32x4 w;
                    w.x = cvtpk(v0[0], v0[1]); w.y = cvtpk(v0[2], v0[3]); w.z = cvtpk(v1[0], v1[1]); w.w = cvtpk(v1[2], v1[3]);
                    *(u32x4*)(rp + bj * HALF) = w;
                }
            }
    }
};
struct EpiGate {
    static constexpr bool PERM = true;
    bf16_t* Gt; const float* ssq; const float* bias;
    DEV void operator()(const Acc& acc, const Unit& u, int wr, int wc, int fr, int fq) const {
        const int row0 = u.pm * BM + wr * 64 + fr, col0 = u.pn * BM + wc * 32 + 8 * fq;
        f32x4 bv[2][2];
#pragma unroll
        for (int bj = 0; bj < 2; ++bj)
#pragma unroll
            for (int n = 0; n < 2; ++n) bv[bj][n] = *(const f32x4*)(bias + col0 + bj * HALF + 4 * n);
#pragma unroll
        for (int ai = 0; ai < 2; ++ai)
#pragma unroll
            for (int m = 0; m < 4; ++m) {
                const int row = row0 + ai * HALF + m * 16; const float rs = row_rstd(ssq, row);
#pragma unroll
                for (int bj = 0; bj < 2; ++bj) {
                    const f32x4 v0 = acc[ai][bj][m][0] * rs + bv[bj][0], v1 = acc[ai][bj][m][1] * rs + bv[bj][1]; u32x4 w;
                    w.x = cvtpk(sigm(v0[0]), sigm(v0[1])); w.y = cvtpk(sigm(v0[2]), sigm(v0[3])); w.z = cvtpk(sigm(v1[0]), sigm(v1[1])); w.w = cvtpk(sigm(v1[2]), sigm(v1[3]));
                    *(u32x4*)(Gt + (size_t)row * GW + col0 + bj * HALF) = w;
                }
            }
    }
};
struct EpiMerge {
    static constexpr bool PERM = true;
    bf16_t* Mg; const bf16_t* Gt;
    DEV void operator()(const Acc& acc, const Unit& u, int wr, int wc, int fr, int fq) const {
        const int row0 = u.pm * BM + wr * 64 + fr, col0 = u.pn * BM + wc * 32 + 8 * fq;
#pragma unroll
        for (int ai = 0; ai < 2; ++ai)
#pragma unroll
            for (int m = 0; m < 4; ++m) {
                const int row = row0 + ai * HALF + m * 16;
#pragma unroll
                for (int bj = 0; bj < 2; ++bj) {
                    const u32x4 g = *(const u32x4*)(Gt + (size_t)row * GW + u.br * D + col0 + bj * HALF);
                    bf16_t* mp = Mg + (size_t)row * D + col0 + bj * HALF;
                    const f32x4 a0 = acc[ai][bj][m][0], a1 = acc[ai][bj][m][1];
                    float v[8] = {bf_lo(g.x) * a0[0], bf_hi(g.x) * a0[1], bf_lo(g.y) * a0[2], bf_hi(g.y) * a0[3], bf_lo(g.z) * a1[0], bf_hi(g.z) * a1[1], bf_lo(g.w) * a1[2], bf_hi(g.w) * a1[3]};
                    if (u.br != 0) { const u32x4 o = *(const u32x4*)mp;
                        v[0] += bf_lo(o.x); v[1] += bf_hi(o.x); v[2] += bf_lo(o.y); v[3] += bf_hi(o.y); v[4] += bf_lo(o.z); v[5] += bf_hi(o.z); v[6] += bf_lo(o.w); v[7] += bf_hi(o.w); }
                    u32x4 w; w.x = cvtpk(v[0], v[1]); w.y = cvtpk(v[2], v[3]); w.z = cvtpk(v[4], v[5]); w.w = cvtpk(v[6], v[7]);
                    *(u32x4*)mp = w;
                }
            }
        asm volatile("s_waitcnt vmcnt(0)" ::: "memory");
    }
};

template <class Epi, class Sched>
DEV void gemm_phase(LAS unsigned char* lds, const int K, const int lda, const int ldb, const Sched& S, const Epi& E) {
    const int tid = threadIdx.x, wid = __builtin_amdgcn_readfirstlane(tid >> 6), lane = tid & 63, wr = wid >> 2, wc = wid & 3, fr = lane & 15, fq = lane >> 4;
    const int nt = K / BK;
    unsigned voffA[2], voffB[2];
#pragma unroll
    for (int i = 0; i < 2; ++i) { int R, C; stage_rc(tid * 16 + i * 8192, R, C); const int Rb = Epi::PERM ? ((R & ~31) + perm32(R & 31)) : R;
        voffA[i] = (unsigned)(R * lda + C) * 2u; voffB[i] = (unsigned)(Rb * ldb + C) * 2u; }
    const size_t kstep = (size_t)(BK * 2);
    const size_t hstepA = (size_t)HALF * lda * 2, hstepB = (size_t)HALF * ldb * 2;
    const unsigned ldsw = (unsigned)wid * 1024u;
    const int aoff = lds_byte(wr * 64 + fr, fq * 8), boff = lds_byte(wc * 32 + fr, fq * 8);
#define PG8_SA(b, h) (((b) * 2 + (h)) * HTB)
#define PG8_SB(b, h) ((4 + (b) * 2 + (h)) * HTB)
#define PG8_STAGE(bufoff, gbase, voff) do { _Pragma("unroll") for (int _i = 0; _i < 2; ++_i) \
        __builtin_amdgcn_global_load_lds((const unsigned*)((const char*)(gbase) + (voff)[_i]), (LAS unsigned*)(lds + (bufoff) + ldsw + _i * 8192), 16, 0, 0); } while (0)
#define PG8_LDA(dst, b, h) do { _Pragma("unroll") for (int m = 0; m < 4; ++m) _Pragma("unroll") for (int k = 0; k < 2; ++k) dst[m][k] = *(const LAS bf16x8*)(lds + PG8_SA(b, h) + aoff + m * 2048 + k * 1024); } while (0)
#define PG8_LDB(dst, b, h) do { _Pragma("unroll") for (int n = 0; n < 2; ++n) _Pragma("unroll") for (int k = 0; k < 2; ++k) dst[n][k] = *(const LAS bf16x8*)(lds + PG8_SB(b, h) + boff + n * 2048 + k * 1024); } while (0)
#define PG8_MMA(ai, bj, At, Bt) do { __builtin_amdgcn_s_setprio(1); _Pragma("unroll") for (int m = 0; m < 4; ++m) _Pragma("unroll") for (int n = 0; n < 2; ++n) _Pragma("unroll") for (int k = 0; k < 2; ++k) \
        acc[ai][bj][m][n] = __builtin_amdgcn_mfma_f32_16x16x32_bf16(Bt[n][k], At[m][k], acc[ai][bj][m][n], 0, 0, 0); __builtin_amdgcn_s_setprio(0); } while (0)
#define PG8_WAIT_V(n) asm volatile("s_waitcnt vmcnt(" #n ")" ::: "memory")
#define PG8_WAIT_L(n) asm volatile("s_waitcnt lgkmcnt(" #n ")" ::: "memory")
#define PG8_BAR __builtin_amdgcn_s_barrier()
#define PG8_SCHED __builtin_amdgcn_sched_barrier(0)
    Unit cur, nxt; int ui = 0;
    if (!S.next(0, cur)) return;
    Acc acc;
#pragma unroll
    for (int a = 0; a < 2; ++a)
#pragma unroll
        for (int b = 0; b < 2; ++b)
#pragma unroll
            for (int m = 0; m < 4; ++m)
#pragma unroll
                for (int n = 0; n < 2; ++n) acc[a][b][m][n] = (f32x4){0.f, 0.f, 0.f, 0.f};
    bf16x8 At[4][2], B0[2][2], B1[2][2];
    const char* cA = S.aptr(cur); const char* cB = S.bptr(cur);
    PG8_STAGE(PG8_SB(0, 0), cB, voffB); PG8_STAGE(PG8_SB(0, 1), cB + hstepB, voffB); PG8_STAGE(PG8_SA(0, 0), cA, voffA); PG8_STAGE(PG8_SA(0, 1), cA + hstepA, voffA);
    if (wr == 1) PG8_BAR;
    PG8_WAIT_V(2); PG8_BAR;
    PG8_STAGE(PG8_SB(1, 0), cB + kstep, voffB); PG8_STAGE(PG8_SA(1, 0), cA + kstep, voffA); PG8_STAGE(PG8_SB(1, 1), cB + hstepB + kstep, voffB);
    PG8_WAIT_V(6); PG8_BAR;
    for (;;) {
        const bool has_next = S.next(ui + 1, nxt);
        const char* nA = has_next ? S.aptr(nxt) : cA; const char* nB = has_next ? S.bptr(nxt) : cB;
        for (int t = 0; t < nt; t += 2) {
            const bool last = (t == nt - 2);
            const char* a1 = cA + (size_t)(t + 1) * kstep;
            const char* a2 = last ? nA : cA + (size_t)(t + 2) * kstep; const char* b2 = last ? nB : cB + (size_t)(t + 2) * kstep;
            const char* a3 = a2 + kstep; const char* b3 = b2 + kstep;
            PG8_LDB(B0, 0, 0); PG8_LDB(B1, 0, 1); PG8_SCHED; PG8_LDA(At, 0, 0); PG8_STAGE(PG8_SA(1, 1), a1 + hstepA, voffA);
            PG8_WAIT_V(8); PG8_WAIT_L(0); PG8_BAR; PG8_MMA(0, 0, At, B0); PG8_MMA(0, 1, At, B1); PG8_BAR; PG8_SCHED;
            PG8_LDA(At, 0, 1); PG8_STAGE(PG8_SB(0, 0), b2, voffB); PG8_STAGE(PG8_SB(0, 1), b2 + hstepB, voffB); PG8_STAGE(PG8_SA(0, 0), a2, voffA);
            PG8_WAIT_V(8); PG8_WAIT_L(0); PG8_BAR; PG8_MMA(1, 0, At, B0); PG8_MMA(1, 1, At, B1); PG8_BAR; PG8_SCHED;
            PG8_LDB(B0, 1, 0); PG8_LDB(B1, 1, 1); PG8_SCHED; PG8_LDA(At, 1, 0); PG8_STAGE(PG8_SA(0, 1), a2 + hstepA, voffA);
            PG8_WAIT_V(8); PG8_WAIT_L(0); PG8_BAR; PG8_MMA(0, 0, At, B0); PG8_MMA(0, 1, At, B1); PG8_BAR; PG8_SCHED;
            PG8_LDA(At, 1, 1); PG8_STAGE(PG8_SB(1, 0), b3, voffB); PG8_STAGE(PG8_SB(1, 1), b3 + hstepB, voffB); PG8_STAGE(PG8_SA(1, 0), a3, voffA);
            PG8_WAIT_V(8); PG8_WAIT_L(0); PG8_BAR; PG8_MMA(1, 0, At, B0); PG8_MMA(1, 1, At, B1); PG8_BAR; PG8_SCHED;
        }
        if (wr == 0) PG8_BAR;
        E(acc, cur, wr, wc, fr, fq);
        if (!has_next) break;
#pragma unroll
        for (int a = 0; a < 2; ++a)
#pragma unroll
            for (int b = 0; b < 2; ++b)
#pragma unroll
                for (int m = 0; m < 4; ++m)
#pragma unroll
                    for (int n = 0; n < 2; ++n) acc[a][b][m][n] = (f32x4){0.f, 0.f, 0.f, 0.f};
        cur = nxt; cA = nA; cB = nB; ++ui;
        if (wr == 1) PG8_BAR;
    }
    PG8_WAIT_V(0);
    PG8_BAR;
#undef PG8_SA
#undef PG8_SB
#undef PG8_STAGE
#undef PG8_LDA
#undef PG8_LDB
#undef PG8_MMA
#undef PG8_WAIT_V
#undef PG8_WAIT_L
#undef PG8_BAR
#undef PG8_SCHED
}
}

DEV void transpose_item(const float* W, int K, int N, bf16_t* WT, int k0, int n0, int dst_row0, const float* gain, float cscale, LAS float* scr, int lane) {
    float wv[32];
#pragma unroll
    for (int i = 0; i < 32; ++i) wv[i] = __builtin_nontemporal_load(W + (size_t)(k0 + 2 * i + (lane >> 5)) * N + n0 + (lane & 31));
    const int c = lane & 7;
    f32x4 g0 = {cscale, cscale, cscale, cscale}, g1 = g0;
    if (gain) { g0 = *(const f32x4*)(gain + k0 + 8 * c) * cscale; g1 = *(const f32x4*)(gain + k0 + 8 * c + 4) * cscale; }
#pragma unroll
    for (int i = 0; i < 32; ++i) scr[(2 * i + (lane >> 5)) * 33 + (lane & 31)] = wv[i];
    asm volatile("s_waitcnt lgkmcnt(0)" ::: "memory");
#pragma unroll
    for (int j = 0; j < 4; ++j) { const int n = (lane >> 3) + 8 * j; const LAS float* s = scr + (8 * c) * 33 + n;
        u32x4 o; o.x = cvtpk(s[0 * 33] * g0[0], s[1 * 33] * g0[1]); o.y = cvtpk(s[2 * 33] * g0[2], s[3 * 33] * g0[3]); o.z = cvtpk(s[4 * 33] * g1[0], s[5 * 33] * g1[1]); o.w = cvtpk(s[6 * 33] * g1[2], s[7 * 33] * g1[3]);
        *(u32x4*)(WT + (size_t)(dst_row0 + n) * K + k0 + 8 * c) = o; }
    asm volatile("s_waitcnt lgkmcnt(0)" ::: "memory");
}
template <int MODE>
DEV void transpose_matrix(const float* W, int K, int N, bf16_t* WT, int row_off, const float* gain, LAS float* scr, int gw, int ngw, int lane) {
    const int nblk = N / 32, nitems = (K / 64) * nblk;
    for (int it0 = gw; it0 < DUPF(0) * nitems; it0 += ngw) {
        const int it = it0 >= nitems ? it0 - nitems : it0;
        const int kb = it / nblk, nb = it % nblk, n0 = 32 * nb;
        const int dr = (MODE == 0 || MODE == 3) ? row_off + n0 : 256 * (n0 >> 7) + 128 * (MODE - 1) + (n0 & 127);
        const float cs = MODE != 3 ? 1.0f : (n0 < O_NK || (n0 >= O_DQ && n0 < O_DK)) ? 0.125f * LOG2E : n0 >= O_MQ ? 0.08838834764831845f * LOG2E : 1.0f;
        transpose_item(W, K, N, WT, 64 * kb, n0, dr, gain, cs, scr, lane);
    }
}
DEV void rowv_to_bf16(const f32x4 (&v)[4], bf16_t* orow, float* ssq_row, int lane) {
    float s = 0.f;
#pragma unroll
    for (int j = 0; j < 4; ++j) s += (v[j][0] * v[j][0] + v[j][1] * v[j][1]) + (v[j][2] * v[j][2] + v[j][3] * v[j][3]);
    s = wave_sum(s);
    u32x2* o8 = (u32x2*)orow + lane;
#pragma unroll
    for (int j = 0; j < 4; ++j) { u32x2 w; w.x = cvtpk(v[j][0], v[j][1]); w.y = cvtpk(v[j][2], v[j][3]); o8[64 * j] = w; }
    if (lane < 16) ssq_row[lane] = lane == 0 ? s : 0.f;
}

#define MFMA32(a, b, c) __builtin_amdgcn_mfma_f32_32x32x16_bf16((a), (b), (c), 0, 0, 0)
typedef short v4i16_t __attribute__((ext_vector_type(4)));
DEV s16x4 vtr(const LAS char* p) { return __builtin_bit_cast(s16x4, __builtin_amdgcn_ds_read_tr16_b64_v4i16((LAS v4i16_t*)p)); }
DEV int crow(int r, int hi) { return (r & 3) + 8 * (r >> 2) + 4 * hi; }
constexpr float NEG_BIG = -3.0e38f, SM_THR = 8.0f;

constexpr int ALDS_V = 0, ALDS_K = 36864, ALDS_X = 70656;
static_assert(ALDS_X + 65536 <= 131072 + 8192, "attention LDS");

template <int NCH> DEV void tile_gload(u32x4 (&st)[NCH / 8], const char* g, size_t gp, int tid) {
#pragma unroll
    for (int i = 0; i < NCH / 8; ++i) { const int c = tid + NTHR * i, row = c / NCH, ch = c % NCH; st[i] = *(const u32x4*)(g + (size_t)row * gp + ch * 16); }
}
template <int NCH, int PITCH> DEV void tile_swrite(const u32x4 (&st)[NCH / 8], LAS char* l, int tid) {
#pragma unroll
    for (int i = 0; i < NCH / 8; ++i) { const int c = tid + NTHR * i, row = c / NCH, ch = c % NCH; *(LAS u32x4*)(l + row * PITCH + ch * 16) = st[i]; }
}
template <int DK, int KP> DEV void qk_tile(f32x16& p0, f32x16& p1, const LAS char* Kt, const bf16x8 (&qf)[DK / 16], int r32, int hi) {
    const LAS char* ka = Kt + r32 * KP + hi * 16;
#pragma unroll
    for (int ks = 0; ks < DK / 16; ++ks) {
        const bf16x8 a0 = *(const LAS bf16x8*)(ka + ks * 32), a1 = *(const LAS bf16x8*)(ka + 32 * KP + ks * 32);
        p0 = MFMA32(a0, qf[ks], p0); p1 = MFMA32(a1, qf[ks], p1);
    }
}
DEV float xhalf_max(float v) { auto rr = __builtin_amdgcn_permlane32_swap(__float_as_uint(v), __float_as_uint(v), false, false); return fmaxf(__uint_as_float(rr[0]), __uint_as_float(rr[1])); }
DEV float xhalf_sum(float v) { auto rr = __builtin_amdgcn_permlane32_swap(__float_as_uint(v), __float_as_uint(v), false, false); return __uint_as_float(rr[0]) + __uint_as_float(rr[1]); }
template <int DV, int VP> DEV void softmax_pv(f32x16& p0, f32x16& p1, f32x16 (&o)[DV / 32], float& mref, float& l, bool first, const LAS char* Vt, int lane) {
    constexpr int ND = DV / 32;
    const int hi = lane >> 5;
    const LAS char* va = Vt + (4 * hi + ((lane & 15) >> 2)) * VP + (16 * ((lane >> 4) & 1) + 4 * (lane & 3)) * 2;
    s16x4 vlo[ND], vhi[ND];
#pragma unroll
    for (int d = 0; d < ND; ++d) { vlo[d] = vtr(va + d * 64); vhi[d] = vtr(va + 8 * VP + d * 64); }
    float mx = fmaxf(p0[0], p1[0]);
#pragma unroll
    for (int r = 1; r < 16; ++r) mx = fmaxf(mx, fmaxf(p0[r], p1[r]));
    mx = xhalf_max(mx);
    if (first || __any(mx > SM_THR)) {
        const float delta = first ? mx : fmaxf(mx, 0.f);
        mref += delta; const float sc = first ? 1.0f : __builtin_amdgcn_exp2f(-delta); l *= sc;
#pragma unroll
        for (int r = 0; r < 16; ++r) { p0[r] -= delta; p1[r] -= delta; }
#pragma unroll
        for (int d = 0; d < ND; ++d)
#pragma unroll
            for (int r = 0; r < 16; ++r) o[d][r] *= sc;
    }
    float s = 0.f;
#pragma unroll
    for (int r = 0; r < 16; ++r) { p0[r] = __builtin_amdgcn_exp2f(p0[r]); p1[r] = __builtin_amdgcn_exp2f(p1[r]); s += p0[r] + p1[r]; }
    l += s;
#pragma unroll
    for (int s4 = 0; s4 < 4; ++s4) {
        u32x4 pw;
        if (s4 == 0) { pw.x = cvtpk(p0[0], p0[1]); pw.y = cvtpk(p0[2], p0[3]); pw.z = cvtpk(p0[4], p0[5]); pw.w = cvtpk(p0[6], p0[7]); }
        else if (s4 == 1) { pw.x = cvtpk(p0[8], p0[9]); pw.y = cvtpk(p0[10], p0[11]); pw.z = cvtpk(p0[12], p0[13]); pw.w = cvtpk(p0[14], p0[15]); }
        else if (s4 == 2) { pw.x = cvtpk(p1[0], p1[1]); pw.y = cvtpk(p1[2], p1[3]); pw.z = cvtpk(p1[4], p1[5]); pw.w = cvtpk(p1[6], p1[7]); }
        else { pw.x = cvtpk(p1[8], p1[9]); pw.y = cvtpk(p1[10], p1[11]); pw.z = cvtpk(p1[12], p1[13]); pw.w = cvtpk(p1[14], p1[15]); }
        const bf16x8 pf = __builtin_bit_cast(bf16x8, pw);
        bf16x8 vf[ND];
#pragma unroll
        for (int d = 0; d < ND; ++d) vf[d] = __builtin_shufflevector(vlo[d], vhi[d], 0, 1, 2, 3, 4, 5, 6, 7);
        if (s4 < 3) {
#pragma unroll
            for (int d = 0; d < ND; ++d) { vlo[d] = vtr(va + (16 * (s4 + 1)) * VP + d * 64); vhi[d] = vtr(va + (16 * (s4 + 1) + 8) * VP + d * 64); }
        }
#pragma unroll
        for (int d = 0; d < ND; ++d) o[d] = MFMA32(vf[d], pf, o[d]);
    }
}
template <int DV> DEV void store_ot(const f32x16 (&o)[DV / 32], float inv, bf16_t* orow, int hi) {
#pragma unroll
    for (int d = 0; d < DV / 32; ++d)
#pragma unroll
        for (int g = 0; g < 4; ++g) { u32x2 w; w.x = cvtpk(o[d][4 * g] * inv, o[d][4 * g + 1] * inv); w.y = cvtpk(o[d][4 * g + 2] * inv, o[d][4 * g + 3] * inv);
            *(u32x2*)(orow + 32 * d + 8 * g + 4 * hi) = w; }
}

struct AttnArgs { const bf16_t* proj; const bf16_t* mkv; bf16_t* att; const float* rpb; const float* lq1; const float* lk1; const float* lq2; const float* lk2; const float* subln; };

DEV void diff_unit(const AttnArgs& A, LAS char* lds, int b, int h, int qb, float lam) {
    constexpr int KP = 272, VP = 320, NT = SEQ / 64, BUFB = 64 * KP + 64 * VP, VOFF = 64 * KP;
    const int tid = threadIdx.x, lane = tid & 63, r32 = lane & 31, hi = lane >> 5, wid = __builtin_amdgcn_readfirstlane(tid >> 6), map = wid >> 2;
    const size_t rowb = (size_t)b * SEQ; const int q0 = qb * 128 + (wid & 3) * 32;
    const bf16_t* qp = A.proj + (rowb + q0 + r32) * INW + O_DQ + h * 128 + map * 64 + hi * 8;
    bf16x8 qf[4];
#pragma unroll
    for (int ks = 0; ks < 4; ++ks) qf[ks] = *(const bf16x8*)(qp + ks * 16);
    const char* kg = (const char*)(A.proj + rowb * INW + O_DK + h * 128); const char* vg = (const char*)(A.proj + rowb * INW + O_DV + h * 128);
    const size_t gp = (size_t)INW * 2, tp = 64 * gp;
    f32x16 o[4];
#pragma unroll
    for (int d = 0; d < 4; ++d)
#pragma unroll
        for (int r = 0; r < 16; ++r) o[d][r] = 0.f;
    float mref = 0.f, l = 0.f;
    const float sl2 = exp2f(-2.0f * (float)(h + 1)) * LOG2E;
    const float qpos = (float)(q0 + r32), qh = qpos - (float)(4 * hi);
    float Bv[16];
#pragma unroll
    for (int r = 0; r < 16; ++r) Bv[r] = sl2 * (float)crow(r, hi);
    int nl = 2 * qb - 1, nr = 2 * qb + 1; bool right = true;
#define NEXT_TILE(T) do { if ((right && nr < NT) || nl < 0) { T = nr++; } else { T = nl--; } right = !right; } while (0)
    u32x4 ks_[2], vs_[2];
    int t_cur = 2 * qb, t_nxt, t_n2 = 0;
    tile_gload<16>(ks_, kg + (size_t)t_cur * tp, gp, tid); tile_gload<16>(vs_, vg + (size_t)t_cur * tp, gp, tid);
    tile_swrite<16, KP>(ks_, lds, tid); tile_swrite<16, VP>(vs_, lds + VOFF, tid);
    NEXT_TILE(t_nxt);
    tile_gload<16>(ks_, kg + (size_t)t_nxt * tp, gp, tid); tile_gload<16>(vs_, vg + (size_t)t_nxt * tp, gp, tid);
    for (int i = 0; i < NT; ++i) {
        LAS char* cb = lds + (i & 1) * BUFB; LAS char* nb = lds + ((i + 1) & 1) * BUFB;
        __syncthreads();
        if (i + 1 < NT) { tile_swrite<16, KP>(ks_, nb, tid); tile_swrite<16, VP>(vs_, nb + VOFF, tid); }
        if (i + 2 < NT) { NEXT_TILE(t_n2); tile_gload<16>(ks_, kg + (size_t)t_n2 * tp, gp, tid); tile_gload<16>(vs_, vg + (size_t)t_n2 * tp, gp, tid); }
        const int k0 = t_cur * 64; const bool diag = (k0 <= q0 + 31) && (k0 + 63 >= q0);
        f32x16 p0, p1;
        if (diag) {
#pragma unroll
            for (int r = 0; r < 16; ++r) { p0[r] = -mref; p1[r] = -mref; }
        } else {
            const float sg = k0 < q0 ? 1.0f : -1.0f, w0 = sg * sl2 * ((float)k0 - qpos) - mref, w1 = w0 + sg * 32.0f * sl2;
#pragma unroll
            for (int r = 0; r < 16; ++r) { p0[r] = fmaf(sg, Bv[r], w0); p1[r] = fmaf(sg, Bv[r], w1); }
        }
        qk_tile<64, KP>(p0, p1, cb + map * 128, qf, r32, hi);
        if (diag) {
            const float dq = qh - (float)k0;
#pragma unroll
            for (int r = 0; r < 16; ++r) { const float kr = (float)((r & 3) + 8 * (r >> 2));
                p0[r] -= sl2 * fabsf(dq - kr); p1[r] -= sl2 * fabsf(dq - (kr + 32.f)); }
        }
        softmax_pv<128, VP>(p0, p1, o, mref, l, i == 0, cb + VOFF, lane);
        t_cur = t_nxt; t_nxt = t_n2;
    }
#undef NEXT_TILE
    l = xhalf_sum(l);
    const float inv = (map ? lam : 1.0f) / l;
    __syncthreads();
    LAS f32x4* xch = (LAS f32x4*)(lds + (wid & 3) * 16384) + lane;
    if (map) {
#pragma unroll
        for (int d = 0; d < 4; ++d)
#pragma unroll
            for (int g = 0; g < 4; ++g) xch[(d * 4 + g) * 64] = (f32x4){o[d][4 * g] * inv, o[d][4 * g + 1] * inv, o[d][4 * g + 2] * inv, o[d][4 * g + 3] * inv};
    }
    __syncthreads();
    if (!map) {
        float ss = 0.f;
#pragma unroll
        for (int d = 0; d < 4; ++d)
#pragma unroll
            for (int g = 0; g < 4; ++g) { const f32x4 x2 = xch[(d * 4 + g) * 64];
#pragma unroll
                for (int i = 0; i < 4; ++i) { const float v = o[d][4 * g + i] * inv - x2[i]; o[d][4 * g + i] = v; ss += v * v; } }
        ss = xhalf_sum(ss);
        const float rn = __builtin_amdgcn_rsqf(ss * (1.0f / 128.0f) + EPS) * 0.8f;
        bf16_t* orow = A.att + (rowb + q0 + r32) * ATTW + 512 + h * 128;
#pragma unroll
        for (int d = 0; d < 4; ++d)
#pragma unroll
            for (int g = 0; g < 4; ++g) { const f32x4 sg = *(const f32x4*)(A.subln + 32 * d + 8 * g + 4 * hi); u32x2 w;
                w.x = cvtpk(o[d][4 * g] * rn * sg[0], o[d][4 * g + 1] * rn * sg[1]); w.y = cvtpk(o[d][4 * g + 2] * rn * sg[2], o[d][4 * g + 3] * rn * sg[3]);
                *(u32x2*)(orow + 32 * d + 8 * g + 4 * hi) = w; }
    }
    __syncthreads();
}
DEV void na_unit(const AttnArgs& A, LAS char* lds, int b, int r, int hg) {
    constexpr int KP = 528, VP = 576;
    const int tid = threadIdx.x, lane = tid & 63, r32 = lane & 31, hi = lane >> 5, wid = __builtin_amdgcn_readfirstlane(tid >> 6), hh = wid >> 1, head = hg * 4 + hh;
    const size_t rowb = (size_t)b * SEQ; const int c = (wid & 1) * 32 + r32;
    const bf16_t* qp = A.proj + (rowb + r * 64 + c) * INW + O_NQ + head * 64 + hi * 8;
    bf16x8 qf[4];
#pragma unroll
    for (int ks = 0; ks < 4; ++ks) qf[ks] = *(const bf16x8*)(qp + ks * 16);
    const int rs = min(max(r - 4, 0), 24), cs = min(max(c - 8, 0), 48);
    const char* kg = (const char*)(A.proj + (rowb + rs * 64) * INW + O_NK + hg * 256); const char* vg = (const char*)(A.proj + (rowb + rs * 64) * INW + O_NV + hg * 256);
    const size_t gp = (size_t)INW * 2;
    const LAS float* tab = (const LAS float*)(lds + ALDS_X) + head * 465;
    f32x16 o[2];
#pragma unroll
    for (int d = 0; d < 2; ++d)
#pragma unroll
        for (int rr = 0; rr < 16; ++rr) o[d][rr] = 0.f;
    float mref = 0.f, l = 0.f;
    u32x4 ks_[4], vs_[4];
    tile_gload<32>(ks_, kg, gp, tid); tile_gload<32>(vs_, vg, gp, tid);
    for (int j = 0; j < 8; ++j) {
        __syncthreads();
        tile_swrite<32, KP>(ks_, lds + ALDS_K, tid); tile_swrite<32, VP>(vs_, lds + ALDS_V, tid);
        __syncthreads();
        if (j + 1 < 8) { tile_gload<32>(ks_, kg + (size_t)(j + 1) * 64 * gp, gp, tid); tile_gload<32>(vs_, vg + (size_t)(j + 1) * 64 * gp, gp, tid); }
        f32x16 p0, p1;
#pragma unroll
        for (int rr = 0; rr < 16; ++rr) { p0[rr] = -mref; p1[rr] = -mref; }
        qk_tile<64, KP>(p0, p1, lds + ALDS_K + hh * 128, qf, r32, hi);
        const int dr = rs + j - r + 7; const LAS float* trow = tab + dr * 31 + 15 - c;
#pragma unroll
        for (int rr = 0; rr < 16; ++rr) {
            const int kc0 = crow(rr, hi), kc1 = kc0 + 32;
            const bool v0 = (unsigned)(kc0 - cs) < 16u, v1 = (unsigned)(kc1 - cs) < 16u;
            const float b0 = trow[v0 ? kc0 : c], b1 = trow[v1 ? kc1 : c];
            p0[rr] = v0 ? p0[rr] + b0 : NEG_BIG; p1[rr] = v1 ? p1[rr] + b1 : NEG_BIG;
        }
        softmax_pv<64, VP>(p0, p1, o, mref, l, j == 0, lds + ALDS_V + hh * 128, lane);
    }
    l = xhalf_sum(l);
    store_ot<64>(o, 1.0f / l, A.att + (rowb + r * 64 + c) * ATTW + head * 64, hi);
}
DEV void mem_unit(const AttnArgs& A, LAS char* lds, int b, int h, int qb) {
    constexpr int KP = 272, VP = 320, NT = 4, BUFB = 64 * KP + 64 * VP, VOFF = 64 * KP;
    const int tid = threadIdx.x, lane = tid & 63, r32 = lane & 31, hi = lane >> 5, wid = __builtin_amdgcn_readfirstlane(tid >> 6);
    const size_t row = (size_t)b * SEQ + qb * 256 + wid * 32 + r32;
    const bf16_t* qp = A.proj + row * INW + O_MQ + h * 128 + hi * 8;
    bf16x8 qf[8];
#pragma unroll
    for (int ks = 0; ks < 8; ++ks) qf[ks] = *(const bf16x8*)(qp + ks * 16);
    const char* kg = (const char*)(A.mkv + (size_t)b * MEMT * 1024 + h * 128); const char* vg = kg + 512 * 2;
    const size_t gp = 1024 * 2, tp = 64 * gp;
    f32x16 o[4];
#pragma unroll
    for (int d = 0; d < 4; ++d)
#pragma unroll
        for (int rr = 0; rr < 16; ++rr) o[d][rr] = 0.f;
    float mref = 0.f, l = 0.f;
    u32x4 ks_[2], vs_[2];
    tile_gload<16>(ks_, kg, gp, tid); tile_gload<16>(vs_, vg, gp, tid);
    __syncthreads();
    tile_swrite<16, KP>(ks_, lds, tid); tile_swrite<16, VP>(vs_, lds + VOFF, tid);
    tile_gload<16>(ks_, kg + tp, gp, tid); tile_gload<16>(vs_, vg + tp, gp, tid);
    for (int t = 0; t < NT; ++t) {
        LAS char* cb = lds + (t & 1) * BUFB; LAS char* nb = lds + ((t + 1) & 1) * BUFB;
        __syncthreads();
        if (t + 1 < NT) { tile_swrite<16, KP>(ks_, nb, tid); tile_swrite<16, VP>(vs_, nb + VOFF, tid); }
        if (t + 2 < NT) { tile_gload<16>(ks_, kg + (size_t)(t + 2) * tp, gp, tid); tile_gload<16>(vs_, vg + (size_t)(t + 2) * tp, gp, tid); }
        f32x16 p0, p1;
#pragma unroll
        for (int rr = 0; rr < 16; ++rr) { p0[rr] = -mref; p1[rr] = -mref; }
        qk_tile<128, KP>(p0, p1, cb, qf, r32, hi);
        softmax_pv<128, VP>(p0, p1, o, mref, l, t == 0, cb + VOFF, lane);
    }
    l = xhalf_sum(l);
    store_ot<128>(o, 1.0f / l, A.att + row * ATTW + 1024 + h * 128, hi);
}
DEV void attention_phase(const AttnArgs& A, LAS char* lds, int c0, int G, int dup) {
    const int lane = threadIdx.x & 63;
    const int c = (G % 8 == 0) ? (c0 % 8) * (G / 8) + c0 / 8 : c0;
    const float lam = __expf(wave_sum(A.lq1[lane] * A.lk1[lane])) - __expf(wave_sum(A.lq2[lane] * A.lk2[lane])) + 0.2f;
    for (int uu = c; uu < dup * DUPF(11) * NB * 4 * 16; uu += G) { const int u = uu & 511; diff_unit(A, lds, u >> 6, (u >> 4) & 3, u & 15, lam); }
    __syncthreads();
    for (int i = threadIdx.x; i < 8 * 15 * 31; i += NTHR) ((LAS float*)(lds + ALDS_X))[i] = A.rpb[i] * LOG2E;
    for (int uu = c; uu < dup * DUPF(12) * NB * 32 * 2; uu += G) { const int u = uu & 511; na_unit(A, lds, u >> 6, (u >> 1) & 31, u & 1); }
    for (int uu = c; uu < dup * DUPF(13) * NB * 4 * 8; uu += G) { const int u = uu & 255; mem_unit(A, lds, u >> 5, (u >> 3) & 3, u & 7); }
}

#define XB_TMO      128
#define XB_XCNT(j)  (256  + 64 * (j))
#define XB_XSUB(j)  (1280 + 64 * (j))
#define XB_XGEN(j)  (2304 + 64 * (j))
#define XB_TOP      3328
#define XB_TOPGEN   3392
#define XCD_BAR_WORDS 3456
#define XB_SPIN_CAP (1u << 18)

__device__ __forceinline__ unsigned xb_ld(unsigned* p)              { return __hip_atomic_load(p, __ATOMIC_RELAXED, __HIP_MEMORY_SCOPE_AGENT); }
__device__ __forceinline__ unsigned xb_add(unsigned* p, unsigned v) { return __hip_atomic_fetch_add(p, v, __ATOMIC_RELAXED, __HIP_MEMORY_SCOPE_AGENT); }
__device__ __forceinline__ unsigned xb_xcc_id() { return (unsigned)__builtin_amdgcn_s_getreg((3 << 11) | 20) & 0xFu; }
#define XB_SPIN(cond, bar) do { unsigned _sp = 0; while (cond) { __builtin_amdgcn_s_sleep(1); \
    if ((++_sp & 255u) == 0u) { if (xb_ld(&(bar)[XB_TMO])) break; if (_sp > XB_SPIN_CAP) { atomicAdd(&(bar)[XB_TMO], 1u); break; } } } } while (0)

struct XcdBarrier {
    unsigned* bar; unsigned x;
    volatile LAS unsigned* st;
};

__device__ __forceinline__ XcdBarrier xcd_barrier_post(unsigned* bar, volatile LAS unsigned* st) {
    XcdBarrier b; b.bar = bar; b.x = xb_xcc_id(); b.st = st;
    if (threadIdx.x == 0) (void)xb_add(&bar[XB_XCNT(b.x)], 1u);
    return b;
}
__device__ __forceinline__ void xcd_barrier_complete(unsigned* bar, unsigned x, unsigned& nloc, unsigned& nx) {
    const unsigned G = gridDim.x * gridDim.y * gridDim.z;
    unsigned sum, cnt, mine, sp = 0u;
    for (;;) {
        sum = 0u; cnt = 0u; mine = 0u;
#pragma unroll
        for (unsigned j = 0; j < 16; ++j) { const unsigned c = xb_ld(&bar[XB_XCNT(j)]); sum += c; cnt += (c > 0u) ? 1u : 0u; mine = (j == x) ? c : mine; }
        if (sum == G) break;
        __builtin_amdgcn_s_sleep(1);
        if ((++sp & 255u) == 0u) { if (xb_ld(&bar[XB_TMO])) break; if (sp > XB_SPIN_CAP) { atomicAdd(&bar[XB_TMO], 1u); break; } }
    }
    nloc = mine > 0u ? mine : 1u; nx = cnt > 0u ? cnt : 1u;
}

__device__ __forceinline__ void xcd_barrier(const XcdBarrier& b) {
    asm volatile("s_waitcnt vmcnt(0)" ::: "memory");
    __syncthreads();
    if (threadIdx.x == 0) {
        unsigned* bar = b.bar;
        __builtin_amdgcn_s_waitcnt(0);
        unsigned nloc = b.st[0], nx = b.st[1];
        if (nloc == 0u) { xcd_barrier_complete(bar, b.x, nloc, nx); b.st[0] = nloc; b.st[1] = nx; }
        const unsigned old = xb_add(&bar[XB_XSUB(b.x)], 1u);
        const unsigned gen = old / nloc;
        if (old + 1u == (gen + 1u) * nloc) {
            __builtin_amdgcn_fence(__ATOMIC_RELEASE, "agent");
            asm volatile("s_waitcnt vmcnt(0)" ::: "memory");
            const unsigned og = xb_add(&bar[XB_TOP], 1u);
            const unsigned tg = og / nx;
            if (og + 1u == (tg + 1u) * nx) xb_add(&bar[XB_TOPGEN], 1u);
            else XB_SPIN(xb_ld(&bar[XB_TOPGEN]) == tg, bar);
            __builtin_amdgcn_fence(__ATOMIC_ACQUIRE, "agent");
            xb_add(&bar[XB_XGEN(b.x)], 1u);
            asm volatile("s_waitcnt vmcnt(0)" ::: "memory");
        } else {
            XB_SPIN(xb_ld(&bar[XB_XGEN(b.x)]) == gen, bar);
            __builtin_amdgcn_fence(__ATOMIC_ACQUIRE, "agent");
            asm volatile("s_waitcnt vmcnt(0)" ::: "memory");
        }
    }
    __syncthreads();
}


struct Args { const float* in[27]; float* out; unsigned char* ws; int ph_lo, ph_hi, coop, pad; };

__global__ void __launch_bounds__(NTHR, 2) fwd_megakernel(Args a) {
    extern __shared__ __attribute__((aligned(16))) unsigned char lds_raw[];
    LAS unsigned char* lds = (LAS unsigned char*)lds_raw;
    cg::grid_group grid = cg::this_grid();
    const int tid = threadIdx.x, lane = tid & 63, wave = __builtin_amdgcn_readfirstlane(tid >> 6);
    const int G = gridDim.x, c = blockIdx.x;
    unsigned char* ws = a.ws;
    const float *x = a.in[0], *mem = a.in[1], *ffn1_norm = a.in[2], *ffn1_wg = a.in[3], *ffn1_wu = a.in[4], *ffn1_wd = a.in[5], *mix_norm = a.in[6], *w_in = a.in[7], *na_rpb = a.in[8],
                *lq1 = a.in[9], *lk1 = a.in[10], *lq2 = a.in[11], *lk2 = a.in[12], *subln = a.in[13], *mem_norm = a.in[14], *w_mem_kv = a.in[15], *w_gate = a.in[16], *b_gate = a.in[17],
                *w_br_na = a.in[18], *w_br_diff = a.in[19], *w_br_mem = a.in[20], *w_out = a.in[21], *ffn2_norm = a.in[22], *ffn2_wg = a.in[23], *ffn2_wu = a.in[24], *ffn2_wd = a.in[25], *final_norm = a.in[26];
    bf16_t *W1T = (bf16_t*)(ws + WS_W1T), *WD1T = (bf16_t*)(ws + WS_WD1T), *WMIX = (bf16_t*)(ws + WS_WMIX), *WBR = (bf16_t*)(ws + WS_WBR), *WOUT = (bf16_t*)(ws + WS_WOUT),
           *W2T = (bf16_t*)(ws + WS_W2T), *WD2T = (bf16_t*)(ws + WS_WD2T), *XB = (bf16_t*)(ws + WS_XB), *MKV = (bf16_t*)(ws + WS_MKV), *HID = (bf16_t*)(ws + WS_HID),
           *PROJ = (bf16_t*)(ws + WS_PROJ), *GATES = (bf16_t*)(ws + WS_GATES), *ATT = (bf16_t*)(ws + WS_ATT), *X2B = (bf16_t*)(ws + WS_X2B);
    float* SSQ = (float*)(ws + WS_SSQ); float* out = a.out;
    const int lo = a.ph_lo, hi = a.ph_hi;
    volatile LAS unsigned* bst = (volatile LAS unsigned*)(lds + LDS_MISC);
    if (tid < 16) bst[tid] = 0u;
    __syncthreads();
    XcdBarrier bar; bar.bar = (unsigned*)(ws + WS_CTL); bar.x = 0; bar.st = bst;
    if (a.coop) bar = xcd_barrier_post((unsigned*)(ws + WS_CTL), bst);
    if (a.coop == 2) grid.sync();
#define IN(k) (lo <= (k) && (k) < hi)
#define SEAM(k) do { if (IN(k) && IN((k) + 1)) { if (a.coop) xcd_barrier(bar); } } while (0)

    if (IN(0)) {
        LAS float* scr = (LAS float*)(lds + wave * 16384);
        const int gw = c * NWAVES + wave, ngw = G * NWAVES;
        transpose_matrix<1>(ffn1_wg, D, FF, W1T, 0, ffn1_norm, scr, gw, ngw, lane);
        transpose_matrix<2>(ffn1_wu, D, FF, W1T, 0, ffn1_norm, scr, gw, ngw, lane);
        for (int r0 = gw; r0 < DUPF(0) * (M + MEMR); r0 += 2 * ngw) {
            const int rA = r0 >= M + MEMR ? r0 - (M + MEMR) : r0, r1 = r0 + ngw; const bool two = r1 < DUPF(0) * (M + MEMR); const int rB = r1 >= M + MEMR ? r1 - (M + MEMR) : r1;
            const float* pA = rA < M ? x + (size_t)rA * D : mem + (size_t)(rA - M) * D; const float* pB = rB < M ? x + (size_t)rB * D : mem + (size_t)(rB - M) * D;
            f32x4 va[4], vb[4];
#pragma unroll
            for (int j = 0; j < 4; ++j) va[j] = ((const f32x4*)pA)[lane + 64 * j];
            if (two) {
#pragma unroll
                for (int j = 0; j < 4; ++j) vb[j] = ((const f32x4*)pB)[lane + 64 * j];
            }
            rowv_to_bf16(va, XB + (size_t)rA * D, SSQ + (size_t)rA * 16, lane);
            if (two) rowv_to_bf16(vb, XB + (size_t)rB * D, SSQ + (size_t)rB * 16, lane);
        }
    }
    SEAM(0);
    if (IN(1)) {
        pg8::SchedRect S; S.so.init(M, 2 * FF); S.A = (const char*)XB; S.B = (const char*)W1T; S.at = (size_t)256 * D * 2; S.bt = (size_t)256 * D * 2; S.G = G; S.c = c; S.dup = DUPF(1);
        pg8::EpiSwiglu E{HID, SSQ};
        pg8::gemm_phase(lds, D, D, D, S, E);
        constexpr int NFULL = ((M / 256) * (2 * FF / 256)) % 256;
        if (G == 256 && c >= NFULL) {
            LAS float* scr = (LAS float*)(lds + wave * 16384); const int gw = (c - NFULL) * NWAVES + wave, ngw = (G - NFULL) * NWAVES;
            transpose_matrix<0>(ffn1_wd, FF, D, WD1T, 0, nullptr, scr, gw, ngw, lane);
            transpose_matrix<3>(w_in, D, INW, WMIX, 0, mix_norm, scr, gw, ngw, lane);
            transpose_matrix<0>(w_mem_kv, D, 1024, WMIX, INW + GW, mem_norm, scr, gw, ngw, lane);
            transpose_matrix<0>(w_gate, D, GW, WMIX, INW, mix_norm, scr, gw, ngw, lane);
        } else if (G != 256) {
            LAS float* scr = (LAS float*)(lds + wave * 16384); const int gw = c * NWAVES + wave, ngw = G * NWAVES;
            transpose_matrix<0>(ffn1_wd, FF, D, WD1T, 0, nullptr, scr, gw, ngw, lane);
            transpose_matrix<3>(w_in, D, INW, WMIX, 0, mix_norm, scr, gw, ngw, lane);
            transpose_matrix<0>(w_mem_kv, D, 1024, WMIX, INW + GW, mem_norm, scr, gw, ngw, lane);
            transpose_matrix<0>(w_gate, D, GW, WMIX, INW, mix_norm, scr, gw, ngw, lane);
        }
    }
    SEAM(1);
    if (IN(2)) {
        pg8::SchedRect S; S.so.init(M, D); S.A = (const char*)HID; S.B = (const char*)WD1T; S.at = (size_t)256 * FF * 2; S.bt = (size_t)256 * FF * 2; S.G = G; S.c = c; S.dup = DUPF(2);
        pg8::EpiResid E{x, out, XB, SSQ, 0.5f};
        pg8::gemm_phase(lds, FF, FF, FF, S, E);
    }
    SEAM(2);
    if (IN(3)) {
        pg8::SchedP3 S; S.so.init(M, INW); S.A = (const char*)XB; S.B = (const char*)WMIX; S.at = (size_t)256 * D * 2; S.bt = (size_t)256 * D * 2; S.G = G; S.c = c; S.dup = DUPF(3);
        pg8::EpiProj E{PROJ, MKV, SSQ};
        pg8::gemm_phase(lds, D, D, D, S, E);
        constexpr int NFULL = ((M / 256) * (INW / 256) + 32) % 256;
        {
            const bool part = (G == 256); if (!part || c >= NFULL) {
            LAS float* scr = (LAS float*)(lds + wave * 16384); const int gw = (part ? c - NFULL : c) * NWAVES + wave, ngw = (part ? G - NFULL : G) * NWAVES;
            transpose_matrix<0>(w_br_na, 512, D, WBR, 0, nullptr, scr, gw, ngw, lane);
            transpose_matrix<0>(w_br_diff, 512, D, WBR, D, nullptr, scr, gw, ngw, lane);
            transpose_matrix<0>(w_br_mem, 512, D, WBR, 2 * D, nullptr, scr, gw, ngw, lane);
            transpose_matrix<0>(w_out, D, D, WOUT, 0, nullptr, scr, gw, ngw, lane);
            transpose_matrix<1>(ffn2_wg, D, FF, W2T, 0, ffn2_norm, scr, gw, ngw, lane);
            transpose_matrix<2>(ffn2_wu, D, FF, W2T, 0, ffn2_norm, scr, gw, ngw, lane);
            transpose_matrix<0>(ffn2_wd, FF, D, WD2T, 0, nullptr, scr, gw, ngw, lane);
            }
        }
    }
    SEAM(3);
    if (IN(4)) {
        const AttnArgs A{PROJ, MKV, ATT, na_rpb, lq1, lk1, lq2, lk2, subln};
        attention_phase(A, (LAS char*)lds, c, G, DUPF(4));
    }
    SEAM(4);
    if (IN(5)) {
        pg8::SchedRect S; S.so.init(M, GW); S.A = (const char*)XB; S.B = (const char*)(WMIX + (size_t)INW * D); S.at = (size_t)256 * D * 2; S.bt = (size_t)256 * D * 2; S.G = G; S.c = c; S.dup = DUPF(5);
        pg8::EpiGate E{GATES, SSQ, b_gate};
        pg8::gemm_phase(lds, D, D, D, S, E);
    }
    SEAM(5);
    if (IN(6)) {
        pg8::SchedBr S; S.so.init(M, D); S.A = (const char*)ATT; S.B = (const char*)WBR; S.at = (size_t)256 * ATTW * 2; S.bt = (size_t)256 * 512 * 2; S.G = G; S.c = c; S.dup = DUPF(6);
        pg8::EpiMerge E{XB, GATES};
        pg8::gemm_phase(lds, 512, ATTW, 512, S, E);
    }
    SEAM(6);
    if (IN(7)) {
        pg8::SchedRect S; S.so.init(M, D); S.A = (const char*)XB; S.B = (const char*)WOUT; S.at = (size_t)256 * D * 2; S.bt = (size_t)256 * D * 2; S.G = G; S.c = c; S.dup = 1;
        pg8::EpiResid E{out, out, X2B, SSQ, 1.0f};
        pg8::gemm_phase(lds, D, D, D, S, E);
    }
    SEAM(7);
    if (IN(8)) {
        pg8::SchedRect S; S.so.init(M, 2 * FF); S.A = (const char*)X2B; S.B = (const char*)W2T; S.at = (size_t)256 * D * 2; S.bt = (size_t)256 * D * 2; S.G = G; S.c = c; S.dup = DUPF(8);
        pg8::EpiSwiglu E{HID, SSQ};
        pg8::gemm_phase(lds, D, D, D, S, E);
    }
    SEAM(8);
    if (IN(9)) {
        pg8::SchedRect S; S.so.init(M, D); S.A = (const char*)HID; S.B = (const char*)WD2T; S.at = (size_t)256 * FF * 2; S.bt = (size_t)256 * FF * 2; S.G = G; S.c = c; S.dup = 1;
        pg8::EpiResid E{out, out, nullptr, SSQ, 0.5f};
        pg8::gemm_phase(lds, FF, FF, FF, S, E);
    }
    SEAM(9);
    if (a.coop) for (int i_ = 0; i_ < PROBE_SYNCS; ++i_) xcd_barrier(bar);
    if (IN(10)) {
        const int gw = c * NWAVES + wave, ngw = G * NWAVES;
        f32x4 gn[4];
#pragma unroll
        for (int j = 0; j < 4; ++j) gn[j] = ((const f32x4*)final_norm)[lane + 64 * j];
        for (int r = gw; r < M; r += ngw) {
            const float rs = row_rstd(SSQ, r); f32x4* p = (f32x4*)(out + (size_t)r * D) + lane;
#pragma unroll
            for (int j = 0; j < 4; ++j) p[64 * j] = p[64 * j] * rs * gn[j];
        }
    }
#undef IN
#undef SEAM
}

extern "C" void kernel_launch(void* const* d_in, const int* in_sizes, int n_in, void* d_out, int out_size, void* d_ws, size_t ws_size, hipStream_t stream) {
    static int grid = 0;
    if (grid == 0) {
        if (n_in != 27 || out_size != M * D || ws_size < WS_END) { fprintf(stderr, "kernel_launch: unexpected problem (n_in %d out %d ws %zu)\n", n_in, out_size, ws_size); grid = -1; return; }
        int dev = 0, cus = 0, per_cu = 0;
        hipGetDevice(&dev); hipDeviceGetAttribute(&cus, hipDeviceAttributeMultiprocessorCount, dev);
        hipFuncSetAttribute((const void*)fwd_megakernel, hipFuncAttributeMaxDynamicSharedMemorySize, LDS_BYTES);
        if (hipOccupancyMaxActiveBlocksPerMultiprocessor(&per_cu, (const void*)fwd_megakernel, NTHR, LDS_BYTES) != hipSuccess || per_cu < 1) { fprintf(stderr, "kernel_launch: occupancy query says %d\n", per_cu); per_cu = 1; }
        (void)hipGetLastError();
        grid = cus * (per_cu > 1 ? 1 : per_cu);
    }
    if (grid < 0) return;
    Args a{};
    for (int i = 0; i < 27; ++i) a.in[i] = (const float*)d_in[i];
    a.out = (float*)d_out; a.ws = (unsigned char*)d_ws;
    if (MK_N_LAUNCHES == 1) {
        if (hipMemsetAsync((char*)d_ws + WS_CTL, 0, CTL_BYTES, stream) != hipSuccess) { fprintf(stderr, "kernel_launch: memset of the barrier words failed\n"); return; }
        a.ph_lo = 0; a.ph_hi = 11; a.coop = 1;
        void* args[] = {&a};
        hipError_t e = hipLaunchCooperativeKernel((const void*)fwd_megakernel, dim3(grid), dim3(NTHR), args, LDS_BYTES, stream);
        if (e != hipSuccess) fprintf(stderr, "cooperative launch failed: %s (grid %d)\n", hipGetErrorString(e), grid);
    } else {
        for (int p = 0; p < 11; ++p) { a.ph_lo = p; a.ph_hi = p + 1; a.coop = 0; hipLaunchKernelGGL(fwd_megakernel, dim3(grid), dim3(NTHR), LDS_BYTES, stream, a); }
    }
}
```
